# Optimizing an MI355X kernel written in HIP

```python
import math
import jax
import jax.numpy as jnp
from jax import lax
import numpy as np

D_MODEL = 2048
BATCH = 4
SEQ = 4096
DEPTH = 2

HEAD_DIM = 128
A_HEADS = 6
B_HEADS = 4
C_HEADS = 6
B_QK_DIM = 64
DILATED_CONFIGS = ((128, 1), (512, 4), (2048, 16))
Q_BLOCK = 128
MLSTM_CHUNK = 128
CONV_WIDTH = 3
MEM_LEN = 256
X_HEADS = 4
X_HEAD_DIM = D_MODEL // X_HEADS
D_FF = 4 * D_MODEL
FORGET_BIAS = 3.0
EPS = 1e-6
NEG = -1e30

A_W = A_HEADS * HEAD_DIM
B_QK_W = B_HEADS * 2 * B_QK_DIM
B_V_W = B_HEADS * HEAD_DIM
C_W = C_HEADS * HEAD_DIM
N_GATES = 4 * C_HEADS
N_MIX_HEADS = A_HEADS + B_HEADS + C_HEADS
MIX_W = N_MIX_HEADS * HEAD_DIM
IN_SPLITS = (A_W, A_W, A_W, B_QK_W, B_QK_W, B_V_W, 2 * C_W, C_W, C_W, N_GATES)
IN_W = 3 * A_W + 2 * B_QK_W + B_V_W + 4 * C_W + N_GATES
F32 = jnp.float32

kernel_name = 'hybrid_dilated_diff_mlstm_encoder'


def rmsnorm(x, g):
    xf = x.astype(F32)
    y = xf * lax.rsqrt(jnp.mean(xf * xf, axis=-1, keepdims=True) + EPS)
    return (y * g.astype(F32)).astype(x.dtype)


def alibi_slopes(n_heads):
    return jnp.asarray(2.0 ** (-8.0 * np.arange(1, n_heads + 1) / n_heads), dtype=F32)


def split_heads(u, n_heads):
    b, t, _ = u.shape
    return u.reshape(b, t, n_heads, -1).transpose(0, 2, 1, 3)


def centred_conv(u, w):
    k, t = w.shape[0], u.shape[1]
    left = k // 2
    up = jnp.pad(u, ((0, 0), (left, k - 1 - left), (0, 0)))
    out = up[:, 0:t] * w[0]
    for j in range(1, k):
        out = out + up[:, j:j + t] * w[j]
    return out


def dilated_window_attn(q, k, v, slopes, window, dilation):
    b, h, t, dh = q.shape
    r = dilation
    half = window // (2 * r)
    n_sub = t // r
    nb = -(-n_sub // half)
    lp = nb * half

    def to_sub(u):
        return u.reshape(b, h, n_sub, r, dh).transpose(0, 1, 3, 2, 4)

    qb = jnp.pad(to_sub(q), ((0, 0), (0, 0), (0, 0), (0, lp - n_sub), (0, 0))).reshape(b, h, r, nb, half, dh)

    def band(u):
        up = jnp.pad(to_sub(u), ((0, 0), (0, 0), (0, 0), (half, lp - n_sub + half), (0, 0)))
        up = up.reshape(b, h, r, nb + 2, half, dh)
        return jnp.concatenate([up[:, :, :, 0:nb], up[:, :, :, 1:nb + 1], up[:, :, :, 2:nb + 2]], axis=4)

    kb, vb = band(k), band(v)
    qi = jnp.arange(nb)[:, None] * half + jnp.arange(half)[None, :]
    ki = jnp.arange(nb)[:, None] * half + jnp.arange(3 * half)[None, :] - half
    delta = jnp.abs(qi[:, :, None] - ki[:, None, :])
    valid = (delta <= half) & (ki[:, None, :] >= 0) & (ki[:, None, :] < n_sub)
    dist = (delta * r).astype(F32)
    s = jnp.einsum('bhrnqd,bhrnkd->bhrnqk', qb, kb).astype(F32) * (dh ** -0.5)
    s = s - slopes[None, :, None, None, None, None] * dist
    s = jnp.where(valid, s, NEG)
    m = jnp.max(s, axis=-1, keepdims=True)
    p = jnp.exp(s - m)
    den = jnp.sum(p, axis=-1)
    o = jnp.einsum('bhrnqk,bhrnkd->bhrnqd', p.astype(v.dtype), vb).astype(F32) / den[..., None]
    lse = m[..., 0] + jnp.log(den)
    o = o.reshape(b, h, r, lp, dh)[:, :, :, :n_sub].transpose(0, 1, 3, 2, 4).reshape(b, h, t, dh)
    lse = lse.reshape(b, h, r, lp)[:, :, :, :n_sub].transpose(0, 1, 3, 2).reshape(b, h, t)
    return o, lse


def dilated_mixture(q, k, v, slopes):
    outs, lses = [], []
    for window, dilation in DILATED_CONFIGS:
        o, lse = dilated_window_attn(q, k, v, slopes, window, dilation)
        outs.append(o)
        lses.append(lse)
    wts = jax.nn.softmax(jnp.stack(lses, axis=0), axis=0)
    return jnp.einsum('gbht,gbhtd->bhtd', wts, jnp.stack(outs, axis=0))


def diff_attention(q1, q2, k1, k2, v, lam, slopes):
    b, h, t, d = q1.shape
    nq = t // Q_BLOCK
    scale = d ** -0.5
    kpos = jnp.arange(t)

    def blocks(u):
        return u.reshape(b, h, nq, Q_BLOCK, d).transpose(2, 0, 1, 3, 4)

    def one_block(args):
        qa, qc, start = args
        qpos = start + jnp.arange(Q_BLOCK)
        bias = -slopes[:, None, None] * jnp.abs(qpos[:, None] - kpos[None, :]).astype(F32)
        s1 = jnp.einsum('bhqd,bhkd->bhqk', qa, k1).astype(F32) * scale + bias
        s2 = jnp.einsum('bhqd,bhkd->bhqk', qc, k2).astype(F32) * scale + bias
        a = jax.nn.softmax(s1, axis=-1) - lam * jax.nn.softmax(s2, axis=-1)
        return jnp.einsum('bhqk,bhkd->bhqd', a.astype(v.dtype), v)

    o = lax.map(one_block, (blocks(q1), blocks(q2), jnp.arange(nq) * Q_BLOCK))
    return o.transpose(1, 2, 0, 3, 4).reshape(b, h, t, v.shape[-1])


def mlstm_chunkwise(q, k, v, log_i, log_f):
    b, nh, t, d = q.shape
    lc = MLSTM_CHUNK
    nc = t // lc

    def chunks(u):
        return jnp.moveaxis(u.reshape((b, nh, nc, lc) + u.shape[3:]), 2, 0)

    q = q.astype(F32) * (d ** -0.5)
    k = k.astype(F32)
    v = v.astype(F32)
    lower = jnp.tril(jnp.ones((lc, lc), dtype=bool))

    def step(carry, xs):
        c_state, n_state, m_state = carry
        qc, kc, vc, li, lf = xs
        bcum = jnp.cumsum(lf, axis=-1)
        dmat = jnp.where(lower, bcum[..., :, None] - bcum[..., None, :] + li[..., None, :], NEG)
        inter = bcum + m_state[..., None]
        m_t = jnp.maximum(inter, jnp.max(dmat, axis=-1))
        dw = jnp.exp(dmat - m_t[..., None])
        iw = jnp.exp(inter - m_t)
        sc = jnp.einsum('bhtd,bhsd->bhts', qc, kc) * dw
        num = iw[..., None] * jnp.einsum('bhtd,bhde->bhte', qc, c_state) + jnp.einsum('bhts,bhse->bhte', sc, vc)
        den = iw * jnp.einsum('bhtd,bhd->bht', qc, n_state) + jnp.sum(sc, axis=-1)
        h_out = num / jnp.maximum(jnp.abs(den), jnp.exp(-m_t))[..., None]
        b_last = bcum[..., -1]
        g = b_last[..., None] - bcum + li
        m_new = jnp.maximum(b_last + m_state, jnp.max(g, axis=-1))
        decay = jnp.exp(b_last + m_state - m_new)
        gw = jnp.exp(g - m_new[..., None])
        c_new = decay[..., None, None] * c_state + jnp.einsum('bhs,bhsd,bhse->bhde', gw, kc, vc)
        n_new = decay[..., None] * n_state + jnp.einsum('bhs,bhsd->bhd', gw, kc)
        return (c_new, n_new, m_new), h_out

    init = (jnp.zeros((b, nh, d, d), F32), jnp.zeros((b, nh, d), F32), jnp.zeros((b, nh), F32))
    _, hs = lax.scan(step, init, (chunks(q), chunks(k), chunks(v), chunks(log_i), chunks(log_f)))
    return jnp.moveaxis(hs, 0, 2).reshape(b, nh, t, d)


def bidirectional_mlstm(q, k, v, li_f, lf_f, li_b, lf_b):
    fwd = mlstm_chunkwise(q, k, v, li_f, lf_f)
    flip = lambda u: jnp.flip(u, axis=2)
    bwd = flip(mlstm_chunkwise(flip(q), flip(k), flip(v), flip(li_b), flip(lf_b)))
    return fwd + bwd


def hybrid_mixer(hn, layer, w_in, conv_w, gate_b, diff_lambda, head_norm_g, w_out):
    b, t, _ = hn.shape
    proj = hn @ w_in
    aq, ak, av, bq, bk, bv, cqk, cv, co, cg = jnp.split(proj, np.cumsum(IN_SPLITS)[:-1].tolist(), axis=-1)

    o_a = dilated_mixture(split_heads(aq, A_HEADS), split_heads(ak, A_HEADS), split_heads(av, A_HEADS),
                          alibi_slopes(A_HEADS))

    bq = bq.reshape(b, t, B_HEADS, 2, B_QK_DIM).transpose(3, 0, 2, 1, 4)
    bk = bk.reshape(b, t, B_HEADS, 2, B_QK_DIM).transpose(3, 0, 2, 1, 4)
    lam_init = 0.8 - 0.6 * math.exp(-0.3 * layer)
    lq1, lk1, lq2, lk2 = diff_lambda.astype(F32)
    lam = jnp.exp(jnp.sum(lq1 * lk1)) - jnp.exp(jnp.sum(lq2 * lk2)) + lam_init
    o_b = diff_attention(bq[0], bq[1], bk[0], bk[1], split_heads(bv, B_HEADS), lam, alibi_slopes(B_HEADS))

    cqk = jax.nn.silu(centred_conv(cqk, conv_w))
    cq, ck = jnp.split(cqk, 2, axis=-1)
    g = (cg.astype(F32) + gate_b.astype(F32)).reshape(b, t, 4, C_HEADS).transpose(2, 0, 3, 1)
    o_c = bidirectional_mlstm(split_heads(cq, C_HEADS), split_heads(ck, C_HEADS), split_heads(cv, C_HEADS),
                              g[0], jax.nn.log_sigmoid(g[1]), g[2], jax.nn.log_sigmoid(g[3]))
    o_c = o_c * jax.nn.sigmoid(split_heads(co, C_HEADS).astype(F32))

    heads = jnp.concatenate([o_a.astype(hn.dtype), o_b.astype(hn.dtype), o_c.astype(hn.dtype)], axis=1)
    heads = rmsnorm(heads, head_norm_g.reshape(N_MIX_HEADS, 1, HEAD_DIM))
    head_scale = np.ones(N_MIX_HEADS, np.float32)
    head_scale[A_HEADS:A_HEADS + B_HEADS] = 1.0 - lam_init
    heads = heads * jnp.asarray(head_scale, dtype=heads.dtype)[:, None, None]
    return heads.transpose(0, 2, 1, 3).reshape(b, t, MIX_W) @ w_out


def cross_attention(hn, mem_n, w_q, w_kv, w_o):
    b, t, _ = hn.shape
    m = mem_n.shape[1]
    q = (hn @ w_q).reshape(b, t, X_HEADS, X_HEAD_DIM)
    kv = (mem_n @ w_kv).reshape(b, m, 2, X_HEADS, X_HEAD_DIM)
    k, v = kv[:, :, 0], kv[:, :, 1]
    s = jnp.einsum('bthd,bmhd->bhtm', q, k).astype(F32) * (X_HEAD_DIM ** -0.5)
    a = jax.nn.softmax(s, axis=-1).astype(v.dtype)
    o = jnp.einsum('bhtm,bmhd->bthd', a, v).reshape(b, t, D_MODEL)
    return o @ w_o


def setup_inputs(seed: int = 0) -> dict:
    key = jax.random.key(seed)
    ks = jax.random.split(key, 18)

    def dense(k, shape, fan_in):
        return jax.random.normal(k, shape, F32) * (fan_in ** -0.5)

    def gain(k, shape):
        return 1.0 + 0.02 * jax.random.normal(k, shape, F32)

    gate_offset = jnp.asarray(np.array([0.0, FORGET_BIAS, 0.0, FORGET_BIAS], np.float32))[None, :, None]
    gate_b = (gate_offset + 0.1 * jax.random.normal(ks[5], (DEPTH, 4, C_HEADS), F32)).reshape(DEPTH, N_GATES)
    return {
        'x': jax.random.normal(ks[0], (BATCH, SEQ, D_MODEL), F32),
        'mem': jax.random.normal(ks[1], (BATCH, MEM_LEN, D_MODEL), F32),
        'norm_mix_g': gain(ks[2], (DEPTH, D_MODEL)),
        'w_in': dense(ks[3], (DEPTH, D_MODEL, IN_W), D_MODEL),
        'conv_w': dense(ks[4], (DEPTH, CONV_WIDTH, 2 * C_W), CONV_WIDTH),
        'gate_b': gate_b,
        'diff_lambda': 0.1 * jax.random.normal(ks[6], (DEPTH, 4, B_QK_DIM), F32),
        'head_norm_g': gain(ks[7], (DEPTH, MIX_W)),
        'w_out': dense(ks[8], (DEPTH, MIX_W, D_MODEL), MIX_W),
        'norm_x_g': gain(ks[9], (DEPTH, D_MODEL)),
        'norm_mem_g': gain(ks[10], (DEPTH, D_MODEL)),
        'w_xq': dense(ks[11], (DEPTH, D_MODEL, D_MODEL), D_MODEL),
        'w_xkv': dense(ks[12], (DEPTH, D_MODEL, 2 * D_MODEL), D_MODEL),
        'w_xo': dense(ks[13], (DEPTH, D_MODEL, D_MODEL), D_MODEL),
        'norm_mlp_g': gain(ks[14], (DEPTH, D_MODEL)),
        'w_up': dense(ks[15], (DEPTH, D_MODEL, D_FF), D_MODEL),
        'w_down': dense(ks[16], (DEPTH, D_FF, D_MODEL), D_FF),
        'final_norm_g': gain(ks[17], (D_MODEL,)),
    }


def reference(x, mem, norm_mix_g, w_in, conv_w, gate_b, diff_lambda, head_norm_g, w_out, norm_x_g, norm_mem_g,
              w_xq, w_xkv, w_xo, norm_mlp_g, w_up, w_down, final_norm_g):
    h = x
    for layer in range(DEPTH):
        h = h + hybrid_mixer(rmsnorm(h, norm_mix_g[layer]), layer, w_in[layer], conv_w[layer], gate_b[layer],
                             diff_lambda[layer], head_norm_g[layer], w_out[layer])
        h = h + cross_attention(rmsnorm(h, norm_x_g[layer]), rmsnorm(mem, norm_mem_g[layer]),
                                w_xq[layer], w_xkv[layer], w_xo[layer])
        u = rmsnorm(h, norm_mlp_g[layer]) @ w_up[layer]
        h = h + jnp.square(jax.nn.relu(u)) @ w_down[layer]
    return rmsnorm(h, final_norm_g)
```

```cpp
#include <hip/hip_runtime.h>
#include <cstdio>
#include <cstdint>
#include <cmath>

#ifndef MK_PER_PHASE
#define MK_PER_PHASE 0
#endif
#ifndef MK_SKIP
#define MK_SKIP 0
#endif

#ifndef MK_REP_PHASE
#define MK_REP_PHASE -1
#endif
#ifndef MK_REP_N
#define MK_REP_N 1
#endif

namespace pg8 {
#define PG8_LAS __attribute__((address_space(3)))
typedef unsigned short bf16_t;
typedef short bf16x8 __attribute__((ext_vector_type(8)));
typedef float f32x4 __attribute__((ext_vector_type(4)));
typedef unsigned u32x4 __attribute__((ext_vector_type(4)));
constexpr int BM = 256, BK = 64, HALF = 128, HTB = HALF * BK * 2  , STAGE_BYTES = 8 * HTB, NXCD = 8, WGM = 8;

__host__ __device__ __forceinline__ int lds_byte(int r, int c) { const int st = (r >> 4) * 2 + (c >> 5), rr = r & 15, cc = c & 31, ob = rr * 64 + cc * 2; return st * 1024 + (ob ^ (((ob >> 9) & 1) << 5)); }
__host__ __device__ __forceinline__ void stage_rc(int b, int& R, int& C) { const int st = b / 1024, sb = b % 1024, swz = sb ^ (((sb >> 9) & 1) << 5); R = (st >> 1) * 16 + swz / 64; C = (st & 1) * 32 + (swz % 64) / 2; }
__host__ __device__ __forceinline__ int perm32(int rho) { const int n = rho >> 4, i = rho & 15; return 8 * (i >> 2) + 4 * n + (i & 3); }

struct Unit { int pm, pn; };
struct Gemm { const bf16_t* A; const bf16_t* Bt; int M, N, K; };

struct StaticOrder {
    int nM, nN, nwg, G, c;
    __host__ __device__ void init(int M, int N, int G_, int c_) { nM = M / BM; nN = N / BM; nwg = nM * nN; G = G_; c = c_; }
    __host__ __device__ bool next(int i, Unit& u) const {
        const long L = (long)i * G + c; if (L >= nwg) return false;
        int wgid = (int)L; { const int q = nwg / NXCD, r = nwg % NXCD, xcd = wgid % NXCD, off = wgid / NXCD; wgid = (xcd < r ? xcd * (q + 1) : r * (q + 1) + (xcd - r) * q) + off; }
        const int nig = WGM * nN, gid = wgid / nig, fm = gid * WGM, gsz = (nM - fm) < WGM ? (nM - fm) : WGM;
        u.pm = fm + ((wgid % nig) % gsz); u.pn = (wgid % nig) / gsz; return true;
    }
    __device__ __forceinline__ void a_ready(const Unit&) const {}
    __device__ __forceinline__ void done(const Unit&) const {}
};

__device__ __forceinline__ unsigned cvt_pk_bf16(float lo, float hi) { unsigned r; asm volatile("v_cvt_pk_bf16_f32 %0, %1, %2" : "=v"(r) : "v"(lo), "v"(hi)); return r; }
typedef float f32x2 __attribute__((ext_vector_type(2)));

template <int ACT, bool SIDE> struct EpiBf16 {
    static constexpr bool PERM = true, AFTER_DRAIN = false;
    bf16_t* O; int ldc; float scale; float* side; int side_c0; const float* rss;
    __device__ __forceinline__ void operator()(const f32x4 (&acc)[2][2][4][2], const Unit& u, int wr, int wc, int fr, int fq) const {
        const int row0 = u.pm * BM + wr * 64 + fr; const int col0 = u.pn * BM + wc * 32 + 8 * fq;
        float fac[2][4];
        if (rss) { f32x4 pa_[2][4], pb_[2][4];
#pragma unroll
            for (int ai = 0; ai < 2; ++ai)
#pragma unroll
                for (int m = 0; m < 4; ++m) { const f32x4* pp = (const f32x4*)(rss + (size_t)(row0 + ai * HALF + m * 16) * 32 + fq * 8); pa_[ai][m] = pp[0]; pb_[ai][m] = pp[1]; }
#pragma unroll
            for (int ai = 0; ai < 2; ++ai)
#pragma unroll
                for (int m = 0; m < 4; ++m) { const f32x4 a = pa_[ai][m], b = pb_[ai][m]; float t = ((a[0] + a[1]) + (a[2] + a[3])) + ((b[0] + b[1]) + (b[2] + b[3]));
                    t += __shfl_xor(t, 16); t += __shfl_xor(t, 32); fac[ai][m] = scale / sqrtf(t * (1.f / 2048.f) + 1e-6f); }
        } else {
#pragma unroll
            for (int ai = 0; ai < 2; ++ai)
#pragma unroll
                for (int m = 0; m < 4; ++m) fac[ai][m] = scale; }
#pragma unroll
        for (int ai = 0; ai < 2; ++ai)
#pragma unroll
            for (int m = 0; m < 4; ++m) { const int row = row0 + ai * HALF + m * 16; bf16_t* rowp = O + (size_t)row * ldc + col0;
                const float f = fac[ai][m];
                if (SIDE) { const int sc = col0 - side_c0;
                    if (sc >= 0 && sc < 24) { float* sp = side + (size_t)row * 24 + sc; *(f32x4*)sp = acc[ai][0][m][0] * f; *(f32x4*)(sp + 4) = acc[ai][0][m][1] * f; } }
#pragma unroll
                for (int bj = 0; bj < 2; ++bj) { f32x4 v0 = acc[ai][bj][m][0] * f, v1 = acc[ai][bj][m][1] * f;
                    if (ACT == 1) {
#pragma unroll
                        for (int e = 0; e < 4; ++e) { const float a = fmaxf(v0[e], 0.f), b = fmaxf(v1[e], 0.f); v0[e] = a * a; v1[e] = b * b; } }
                    u32x4 w; w.x = cvt_pk_bf16(v0[0], v0[1]); w.y = cvt_pk_bf16(v0[2], v0[3]); w.z = cvt_pk_bf16(v1[0], v1[1]); w.w = cvt_pk_bf16(v1[2], v1[3]);
                    *(u32x4*)(rowp + bj * HALF) = w; } }
    }
};
template <bool BASE_F32> struct EpiResBf16 {
    static constexpr bool PERM = true, AFTER_DRAIN = false;
    const void* base; bf16_t* hb; float* ss;
    __device__ __forceinline__ void operator()(const f32x4 (&acc)[2][2][4][2], const Unit& u, int wr, int wc, int fr, int fq) const {
        const int row0 = u.pm * BM + wr * 64 + fr, col0 = u.pn * BM + wc * 32 + 8 * fq;
#pragma unroll
        for (int ai = 0; ai < 2; ++ai) {
            f32x4 b0[4][2], b1[4][2];
#pragma unroll
            for (int m = 0; m < 4; ++m)
#pragma unroll
                for (int bj = 0; bj < 2; ++bj) { const size_t o = (size_t)(row0 + ai * HALF + m * 16) * 2048 + col0 + bj * HALF;
                    if (BASE_F32) { b0[m][bj] = *(const f32x4*)((const float*)base + o); b1[m][bj] = *(const f32x4*)((const float*)base + o + 4); }
                    else { const u32x4 w = *(const u32x4*)((const bf16_t*)base + o);
                        b0[m][bj] = (f32x4){__uint_as_float(w.x << 16), __uint_as_float(w.x & 0xffff0000u), __uint_as_float(w.y << 16), __uint_as_float(w.y & 0xffff0000u)};
                        b1[m][bj] = (f32x4){__uint_as_float(w.z << 16), __uint_as_float(w.z & 0xffff0000u), __uint_as_float(w.w << 16), __uint_as_float(w.w & 0xffff0000u)}; } }
            asm volatile("" ::: "memory");
#pragma unroll
            for (int m = 0; m < 4; ++m) { const int row = row0 + ai * HALF + m * 16; const size_t off = (size_t)row * 2048 + col0; float s2 = 0.f;
#pragma unroll
                for (int bj = 0; bj < 2; ++bj) { const size_t o = off + bj * HALF;
                    const f32x4 v0 = b0[m][bj] + acc[ai][bj][m][0], v1 = b1[m][bj] + acc[ai][bj][m][1];
                    s2 += ((v0[0] * v0[0] + v0[1] * v0[1]) + (v0[2] * v0[2] + v0[3] * v0[3])) + ((v1[0] * v1[0] + v1[1] * v1[1]) + (v1[2] * v1[2] + v1[3] * v1[3]));
                    u32x4 w2; w2.x = cvt_pk_bf16(v0[0], v0[1]); w2.y = cvt_pk_bf16(v0[2], v0[3]); w2.z = cvt_pk_bf16(v1[0], v1[1]); w2.w = cvt_pk_bf16(v1[2], v1[3]);
                    *(u32x4*)(hb + o) = w2; }
                s2 += __shfl_xor(s2, 16); s2 += __shfl_xor(s2, 32);
                if (fq == 0) ss[(size_t)row * 32 + u.pn * 4 + wc] = s2; } }
    }
};

template <class Epi, class Sched, bool ALIGN_EPI = false, bool SP2 = false>
__device__ __forceinline__ void gemm_phase(PG8_LAS unsigned char* lds, const Gemm g, const Sched& S, const Epi& E) {
    int tid_ = threadIdx.x; asm volatile("" : "+v"(tid_)); const int tid = tid_, wid = __builtin_amdgcn_readfirstlane(tid >> 6), lane = tid & 63, wr = wid >> 2, wc = wid & 3, fr = lane & 15, fq = lane >> 4;
    const int K = g.K, nt = K / BK;
    unsigned voffA[2], voffB[2];
#pragma unroll
    for (int i = 0; i < 2; ++i) { int R, C; stage_rc(tid * 16 + i * 8192, R, C); const int Rb = Epi::PERM ? ((R & ~31) + perm32(R & 31)) : R;
        voffA[i] = (unsigned)(R * K + C) * 2u; voffB[i] = (unsigned)(Rb * K + C) * 2u; }
    const size_t kstep = (size_t)(BK * 2);
    const size_t hstep = (size_t)HALF * K * 2;
    const size_t tstep = 2 * hstep;
    const unsigned ldsw = (unsigned)wid * 1024u;
    const int aoff = lds_byte(wr * 64 + fr, fq * 8), boff = lds_byte(wc * 32 + fr, fq * 8);
#define PG8_SA(b, h) (((b) * 2 + (h)) * HTB)
#define PG8_SB(b, h) ((4 + (b) * 2 + (h)) * HTB)
#define PG8_STAGE(bufoff, gbase, voff) do { _Pragma("unroll") for (int _i = 0; _i < 2; ++_i) \
        __builtin_amdgcn_global_load_lds((const unsigned*)((const char*)(gbase) + (voff)[_i]), (PG8_LAS unsigned*)(lds + (bufoff) + ldsw + _i * 8192), 16, 0, 0); } while (0)
#define PG8_LDA(dst, b, h) do { _Pragma("unroll") for (int m = 0; m < 4; ++m) _Pragma("unroll") for (int k = 0; k < 2; ++k) dst[m][k] = *(const PG8_LAS bf16x8*)(lds + PG8_SA(b, h) + aoff + m * 2048 + k * 1024); } while (0)
#define PG8_LDB(dst, b, h) do { _Pragma("unroll") for (int n = 0; n < 2; ++n) _Pragma("unroll") for (int k = 0; k < 2; ++k) dst[n][k] = *(const PG8_LAS bf16x8*)(lds + PG8_SB(b, h) + boff + n * 2048 + k * 1024); } while (0)
#define PG8_MMA(ai, bj, At, Bt) do { __builtin_amdgcn_s_setprio(1); _Pragma("unroll") for (int m = 0; m < 4; ++m) _Pragma("unroll") for (int n = 0; n < 2; ++n) _Pragma("unroll") for (int k = 0; k < 2; ++k) \
        acc[ai][bj][m][n] = __builtin_amdgcn_mfma_f32_16x16x32_bf16(Bt[n][k], At[m][k], acc[ai][bj][m][n], 0, 0, 0); __builtin_amdgcn_s_setprio(0); } while (0)
#define PG8_WAIT_V(n) asm volatile("s_waitcnt vmcnt(" #n ")" ::: "memory")
#define PG8_WAIT_L(n) asm volatile("s_waitcnt lgkmcnt(" #n ")" ::: "memory")
#define PG8_BAR __builtin_amdgcn_s_barrier()
#define PG8_SCHED __builtin_amdgcn_sched_barrier(0)
    Unit cur, nxt; int ui = 0;
    if (!S.next(0, cur)) return;
    f32x4 acc[2][2][4][2];
#pragma unroll
    for (int a = 0; a < 2; ++a)
#pragma unroll
        for (int b = 0; b < 2; ++b)
#pragma unroll
            for (int m = 0; m < 4; ++m)
#pragma unroll
                for (int n = 0; n < 2; ++n) acc[a][b][m][n] = (f32x4){0.f, 0.f, 0.f, 0.f};
    bf16x8 At[4][2], B0[2][2], B1[2][2];
    const char* cA = (const char*)g.A + (size_t)cur.pm * tstep; const char* cB = (const char*)g.Bt + (size_t)cur.pn * tstep;
    S.a_ready(cur);
    if constexpr (SP2) {
        PG8_STAGE(PG8_SB(0, 0), cB, voffB); PG8_STAGE(PG8_SB(0, 1), cB + hstep, voffB); PG8_STAGE(PG8_SA(0, 0), cA, voffA); PG8_STAGE(PG8_SA(0, 1), cA + hstep, voffA);
        if (wr == 1) PG8_BAR;
        PG8_WAIT_V(2); PG8_BAR;
        PG8_STAGE(PG8_SB(1, 0), cB + kstep, voffB); PG8_STAGE(PG8_SA(1, 0), cA + kstep, voffA); PG8_STAGE(PG8_SB(1, 1), cB + hstep + kstep, voffB);
        PG8_WAIT_V(6); PG8_BAR;
    } else {
        PG8_STAGE(PG8_SB(0, 0), cB, voffB); PG8_STAGE(PG8_SA(0, 0), cA, voffA); PG8_STAGE(PG8_SB(0, 1), cB + hstep, voffB); PG8_STAGE(PG8_SA(0, 1), cA + hstep, voffA);
        if (wr == 1) PG8_BAR;
        PG8_WAIT_V(4); PG8_BAR;
        PG8_STAGE(PG8_SB(1, 0), cB + kstep, voffB); PG8_STAGE(PG8_SA(1, 0), cA + kstep, voffA); PG8_STAGE(PG8_SB(1, 1), cB + hstep + kstep, voffB);
        PG8_WAIT_V(6); PG8_BAR;
    }
    for (;;) {
        const bool has_next = S.next(ui + 1, nxt);
        const char* nA = has_next ? (const char*)g.A + (size_t)nxt.pm * tstep : cA; const char* nB = has_next ? (const char*)g.Bt + (size_t)nxt.pn * tstep : cB;
        for (int t = 0; t < nt; t += 2) {
            const bool last = (t == nt - 2);
            const char* a1 = cA + (size_t)(t + 1) * kstep;
            const char* a2 = last ? nA : cA + (size_t)(t + 2) * kstep; const char* b2 = last ? nB : cB + (size_t)(t + 2) * kstep;
            const char* a3 = a2 + kstep; const char* b3 = b2 + kstep;
            if (last && has_next) S.a_ready(nxt);
            if constexpr (SP2) {
            PG8_LDB(B0, 0, 0); PG8_LDB(B1, 0, 1); PG8_SCHED; PG8_LDA(At, 0, 0); PG8_STAGE(PG8_SA(1, 1), a1 + hstep, voffA);
            PG8_WAIT_V(8); PG8_WAIT_L(0); PG8_BAR; PG8_MMA(0, 0, At, B0); PG8_MMA(0, 1, At, B1); PG8_BAR; PG8_SCHED;
            PG8_LDA(At, 0, 1); PG8_STAGE(PG8_SB(0, 0), b2, voffB); PG8_STAGE(PG8_SB(0, 1), b2 + hstep, voffB); PG8_STAGE(PG8_SA(0, 0), a2, voffA);
            PG8_WAIT_V(8); PG8_WAIT_L(0); PG8_BAR; PG8_MMA(1, 0, At, B0); PG8_MMA(1, 1, At, B1); PG8_BAR; PG8_SCHED;
            PG8_LDB(B0, 1, 0); PG8_LDB(B1, 1, 1); PG8_SCHED; PG8_LDA(At, 1, 0); PG8_STAGE(PG8_SA(0, 1), a2 + hstep, voffA);
            PG8_WAIT_V(8); PG8_WAIT_L(0); PG8_BAR; PG8_MMA(0, 0, At, B0); PG8_MMA(0, 1, At, B1); PG8_BAR; PG8_SCHED;
            PG8_LDA(At, 1, 1); PG8_STAGE(PG8_SB(1, 0), b3, voffB); PG8_STAGE(PG8_SB(1, 1), b3 + hstep, voffB); PG8_STAGE(PG8_SA(1, 0), a3, voffA);
            PG8_WAIT_V(8); PG8_WAIT_L(0); PG8_BAR; PG8_MMA(1, 0, At, B0); PG8_MMA(1, 1, At, B1); PG8_BAR; PG8_SCHED;
            } else {
            PG8_LDB(B0, 0, 0); PG8_SCHED; PG8_LDA(At, 0, 0); PG8_STAGE(PG8_SA(1, 1), a1 + hstep, voffA);
            PG8_WAIT_L(8); PG8_BAR; PG8_WAIT_L(0); PG8_MMA(0, 0, At, B0); PG8_BAR; PG8_SCHED;
            PG8_LDB(B1, 0, 1); PG8_STAGE(PG8_SB(0, 0), b2, voffB);
            PG8_BAR; PG8_WAIT_L(0); PG8_MMA(0, 1, At, B1); PG8_BAR;
            PG8_LDA(At, 0, 1); PG8_STAGE(PG8_SA(0, 0), a2, voffA);
            PG8_BAR; PG8_WAIT_L(0); PG8_MMA(1, 0, At, B0); PG8_BAR; PG8_SCHED;
            PG8_STAGE(PG8_SB(0, 1), b2 + hstep, voffB);
            PG8_WAIT_V(6); PG8_BAR; PG8_MMA(1, 1, At, B1); PG8_BAR;
            PG8_LDB(B0, 1, 0); PG8_SCHED; PG8_LDA(At, 1, 0); PG8_STAGE(PG8_SA(0, 1), a2 + hstep, voffA);
            PG8_WAIT_L(8); PG8_BAR; PG8_WAIT_L(0); PG8_MMA(0, 0, At, B0); PG8_BAR; PG8_SCHED;
            PG8_LDB(B1, 1, 1); PG8_STAGE(PG8_SB(1, 0), b3, voffB);
            PG8_BAR; PG8_WAIT_L(0); PG8_MMA(0, 1, At, B1); PG8_BAR;
            PG8_LDA(At, 1, 1); PG8_STAGE(PG8_SA(1, 0), a3, voffA);
            PG8_BAR; PG8_WAIT_L(0); PG8_MMA(1, 0, At, B0); PG8_BAR; PG8_SCHED;
            PG8_STAGE(PG8_SB(1, 1), b3 + hstep, voffB);
            PG8_WAIT_V(6); PG8_BAR; PG8_MMA(1, 1, At, B1); PG8_BAR;
            }
        }
        if constexpr (ALIGN_EPI) { if (wr == 0) PG8_BAR; }
        if constexpr (!Epi::AFTER_DRAIN) { E(acc, cur, wr, wc, fr, fq); S.done(cur); }
        if (!has_next) break;
#pragma unroll
        for (int a = 0; a < 2; ++a)
#pragma unroll
            for (int b = 0; b < 2; ++b)
#pragma unroll
                for (int m = 0; m < 4; ++m)
#pragma unroll
                    for (int n = 0; n < 2; ++n) acc[a][b][m][n] = (f32x4){0.f, 0.f, 0.f, 0.f};
        cur = nxt; cA = nA; cB = nB; ++ui;
        if constexpr (ALIGN_EPI) { if (wr == 1) PG8_BAR; }
    }
    PG8_WAIT_V(0);
    if constexpr (!ALIGN_EPI) { if (wr == 0) PG8_BAR; }
    PG8_BAR;
    if constexpr (Epi::AFTER_DRAIN) { E.fused(acc, cur, wr, wc, fr, fq, lds, wid, lane); S.done(cur); }
#undef PG8_SA
#undef PG8_SB
#undef PG8_STAGE
#undef PG8_LDA
#undef PG8_LDB
#undef PG8_MMA
#undef PG8_WAIT_V
#undef PG8_WAIT_L
#undef PG8_BAR
#undef PG8_SCHED
}
}

constexpr int DM = 2048, NBATCH = 4, T = 4096, M = NBATCH * T, DEPTH = 2;
constexpr int HD = 128, AH = 6, BH = 4, CH = 6;
constexpr int INW = 6936, INWP = 7168;
constexpr int PA_Q = 0, PA_K = 768, PA_V = 1536, PB_Q = 2304, PB_K = 2816, PB_V = 3328, PC_QK = 3840, PC_V = 5376, PC_O = 6144, PC_G = 6912;
constexpr int MEML = 256, XH = 4, XHD = 512, DFF = 8192, NCH = 32, LC = 128;
constexpr float EPS = 1e-6f, LOG2E = 1.4426950408889634f, LN2 = 0.6931471805599453f;

#define GAS __attribute__((address_space(1)))
#define LAS __attribute__((address_space(3)))
typedef unsigned short bf16;
typedef unsigned v4u __attribute__((ext_vector_type(4)));
typedef float f32x4 __attribute__((ext_vector_type(4)));
typedef float f32x16 __attribute__((ext_vector_type(16)));
typedef short bf16x8 __attribute__((ext_vector_type(8)));
typedef short s16x4 __attribute__((ext_vector_type(4)));
typedef GAS unsigned gu32;
#define RLX_AGENT __ATOMIC_RELAXED, __HIP_MEMORY_SCOPE_AGENT
#define LDS_WAIT() asm volatile("s_waitcnt lgkmcnt(0)" ::: "memory")
#define VM_WAIT() asm volatile("s_waitcnt vmcnt(0)" ::: "memory")
#define SBAR() __builtin_amdgcn_sched_barrier(0)
__device__ __forceinline__ unsigned f2bf(float f) { unsigned u = __builtin_bit_cast(unsigned, f); return (u + 0x7fffu + ((u >> 16) & 1u)) >> 16; }
__device__ __forceinline__ unsigned pk2(float lo, float hi) { return f2bf(lo) | (f2bf(hi) << 16); }
__device__ __forceinline__ float bf2f(unsigned short b) { return __builtin_bit_cast(float, (unsigned)b << 16); }
__device__ __forceinline__ unsigned cvtpk(float lo, float hi) { unsigned r; asm volatile("v_cvt_pk_bf16_f32 %0, %1, %2" : "=v"(r) : "v"(lo), "v"(hi)); return r; }
__device__ __forceinline__ float ex2(float x) { return __builtin_amdgcn_exp2f(x); }
__device__ __forceinline__ bf16x8 pack8(const float* f) { v4u w; w.x = cvtpk(f[0], f[1]); w.y = cvtpk(f[2], f[3]); w.z = cvtpk(f[4], f[5]); w.w = cvtpk(f[6], f[7]); return __builtin_bit_cast(bf16x8, w); }
__device__ __forceinline__ bf16x8 scale8(bf16x8 q, float s) { float f[8];
#pragma unroll
    for (int j = 0; j < 8; ++j) f[j] = bf2f((unsigned short)q[j]) * s;
    return pack8(f); }

#define KSWZ(row, colB) ((row) * 256 + ((colB) ^ (((row) & 7) << 4)))
__device__ __forceinline__ int crow(int r, int hi) { return (r & 3) + 8 * (r >> 2) + 4 * hi; }
__device__ __forceinline__ int v_st(int k, int c) { const int kk = (k & ~0xC) | ((k & 4) << 1) | ((k & 8) >> 1); return ((kk >> 3) * 4 + (c >> 5)) * 512 + ((kk & 7) * 32 + (c & 31)) * 2; }
__device__ __forceinline__ int v_rd_base(int lane) { return ((lane & 3) << 3) | (((lane >> 2) & 3) << 6) | (((lane >> 4) & 1) << 5) | (((lane >> 5) & 1) << 8); }
constexpr int v_rd_off(int d0, int ks, int half) { return d0 * 512 + ks * 4096 + half * 2048; }
template <int OFF> __device__ __forceinline__ s16x4 tr_read(int vb) { s16x4 r; asm volatile("ds_read_b64_tr_b16 %0, %1 offset:%2" : "=&v"(r) : "v"(vb), "i"(OFF) : "memory"); return r; }
#define PK8(L, H) (bf16x8){L[0], L[1], L[2], L[3], H[0], H[1], H[2], H[3]}
__device__ __forceinline__ int lds_addr(const LAS void* p) { return (int)(unsigned)(size_t)p; }

template <int ND, bool ZERO>
__device__ __forceinline__ void qkt(f32x16& p0, f32x16& p1, const LAS char* Ks, const bf16x8* qr, int cboff, int r32, int hi) {
    if (ZERO) {
#pragma unroll
        for (int r = 0; r < 16; ++r) { p0[r] = 0.f; p1[r] = 0.f; } }
#pragma unroll
    for (int d0 = 0; d0 < ND; ++d0) { const int cb = cboff + (d0 * 16 + hi * 8) * 2;
        const bf16x8 b0 = *(const LAS bf16x8*)(Ks + KSWZ(r32, cb));
        const bf16x8 b1 = *(const LAS bf16x8*)(Ks + KSWZ(32 + r32, cb));
        p0 = __builtin_amdgcn_mfma_f32_32x32x16_bf16(b0, qr[d0], p0, 0, 0, 0);
        p1 = __builtin_amdgcn_mfma_f32_32x32x16_bf16(b1, qr[d0], p1, 0, 0, 0); }
}
template <int ND>
__device__ __forceinline__ void qkt_asm(f32x16& p0, f32x16& p1, const int (&ka)[ND], int tile_off, const bf16x8* qr) {
    bf16x8 b0[ND], b1[ND];
#pragma unroll
    for (int d0 = 0; d0 < ND; ++d0) { const int ad = ka[d0] + tile_off;
        asm volatile("ds_read_b128 %0, %1" : "=&v"(b0[d0]) : "v"(ad) : "memory");
        asm volatile("ds_read_b128 %0, %1 offset:8192" : "=&v"(b1[d0]) : "v"(ad) : "memory"); }
    asm volatile("s_waitcnt lgkmcnt(0)" ::: "memory"); SBAR();
#pragma unroll
    for (int d0 = 0; d0 < ND; ++d0) {
        p0 = __builtin_amdgcn_mfma_f32_32x32x16_bf16(b0[d0], qr[d0], p0, 0, 0, 0);
        p1 = __builtin_amdgcn_mfma_f32_32x32x16_bf16(b1[d0], qr[d0], p1, 0, 0, 0); }
}
template <int D0> __device__ __forceinline__ void pv_one(f32x16& od, int vb, bf16x8 pa0, bf16x8 pa1, bf16x8 pa2, bf16x8 pa3) {
    const s16x4 l0 = tr_read<v_rd_off(D0, 0, 0)>(vb), h0 = tr_read<v_rd_off(D0, 0, 1)>(vb), l1 = tr_read<v_rd_off(D0, 1, 0)>(vb), h1 = tr_read<v_rd_off(D0, 1, 1)>(vb);
    const s16x4 l2 = tr_read<v_rd_off(D0, 2, 0)>(vb), h2 = tr_read<v_rd_off(D0, 2, 1)>(vb), l3 = tr_read<v_rd_off(D0, 3, 0)>(vb), h3 = tr_read<v_rd_off(D0, 3, 1)>(vb);
    asm volatile("s_waitcnt lgkmcnt(0)" ::: "memory"); SBAR();
    od = __builtin_amdgcn_mfma_f32_32x32x16_bf16(pa0, PK8(l0, h0), od, 0, 0, 0);
    od = __builtin_amdgcn_mfma_f32_32x32x16_bf16(pa1, PK8(l1, h1), od, 0, 0, 0);
    od = __builtin_amdgcn_mfma_f32_32x32x16_bf16(pa2, PK8(l2, h2), od, 0, 0, 0);
    od = __builtin_amdgcn_mfma_f32_32x32x16_bf16(pa3, PK8(l3, h3), od, 0, 0, 0);
}
template <int BASE> __device__ __forceinline__ bf16x8 pk4(const f32x16& P) {
    const unsigned a0 = cvtpk(P[BASE + 0], P[BASE + 1]), a1 = cvtpk(P[BASE + 2], P[BASE + 3]), b0 = cvtpk(P[BASE + 4], P[BASE + 5]), b1 = cvtpk(P[BASE + 6], P[BASE + 7]);
    auto r0 = __builtin_amdgcn_permlane32_swap(a0, b0, false, false); auto r1 = __builtin_amdgcn_permlane32_swap(a1, b1, false, false);
    v4u w = {r0[0], r1[0], r0[1], r1[1]}; return __builtin_bit_cast(bf16x8, w);
}
__device__ __forceinline__ float xhalf_max(float v) { auto rr = __builtin_amdgcn_permlane32_swap(__float_as_uint(v), __float_as_uint(v), false, false); return fmaxf(__uint_as_float(rr[0]), __uint_as_float(rr[1])); }
__device__ __forceinline__ float xhalf_sum(float v) { auto rr = __builtin_amdgcn_permlane32_swap(__float_as_uint(v), __float_as_uint(v), false, false); return __uint_as_float(rr[0]) + __uint_as_float(rr[1]); }
__device__ __forceinline__ float sm_update(f32x16& p0, f32x16& p1, float& m, float& l) {
    float pmax = p0[0];
#pragma unroll
    for (int r = 1; r < 16; ++r) pmax = fmaxf(pmax, p0[r]);
#pragma unroll
    for (int r = 0; r < 16; ++r) pmax = fmaxf(pmax, p1[r]);
    pmax = xhalf_max(pmax);
    const float mn = fmaxf(m, pmax), alpha = ex2(m - mn); m = mn;
    float ps = 0.f;
#pragma unroll
    for (int r = 0; r < 16; ++r) { p0[r] = ex2(p0[r] - mn); ps += p0[r]; }
#pragma unroll
    for (int r = 0; r < 16; ++r) { p1[r] = ex2(p1[r] - mn); ps += p1[r]; }
    ps = xhalf_sum(ps);
    l = l * alpha + ps; return alpha;
}
template <int NO> __device__ __forceinline__ void row_scale(f32x16 (&o)[NO], float f, LAS float* al, int r32, int hi) {
    if (hi == 0) al[r32] = f;
    LDS_WAIT();
#pragma unroll
    for (int r = 0; r < 16; ++r) { const float a = al[crow(r, hi)];
#pragma unroll
        for (int d = 0; d < NO; ++d) o[d][r] *= a; }
    LDS_WAIT();
}
struct Stg2 { bf16x8 a, b; };
__device__ __forceinline__ void stg_store_k(LAS char* buf, const Stg2& s, int sr, int sc) { *(LAS bf16x8*)(buf + KSWZ(sr, sc * 2)) = s.a; *(LAS bf16x8*)(buf + KSWZ(32 + sr, sc * 2)) = s.b; }
__device__ __forceinline__ void stg_store_v(LAS char* buf, const Stg2& s, int sr, int sc) { *(LAS bf16x8*)(buf + v_st(sr, sc)) = s.a; *(LAS bf16x8*)(buf + v_st(32 + sr, sc)) = s.b; }

__device__ __forceinline__ void k_slot(int s, int& row, int& col) { row = s >> 4; col = ((s & 15) ^ (row & 7)) * 8; }
__device__ __forceinline__ void v_slot(int s, int& row, int& col) { const int sub = s >> 5, w32 = s & 31, kk = (sub >> 2) * 8 + (w32 >> 2); col = (sub & 3) * 32 + (w32 & 3) * 8; row = (kk & ~0xC) | ((kk & 4) << 1) | ((kk & 8) >> 1); }
__device__ __forceinline__ void glds16(const bf16* g, LAS char* l) { __builtin_amdgcn_global_load_lds((const unsigned*)g, (LAS unsigned*)l, 16, 0, 0); }
#define WAIT_VM(n) asm volatile("s_waitcnt vmcnt(" #n ")" ::: "memory")
#define WG_BAR() do { asm volatile("s_waitcnt lgkmcnt(0)" ::: "memory"); __builtin_amdgcn_s_barrier(); asm volatile("" ::: "memory"); } while (0)

__device__ __forceinline__ float alibi_slope(int h, int nh) { return exp2f(-8.f * (float)(h + 1) / (float)nh); }

__device__ __forceinline__ void diffattn_unit(LAS char* lds, const bf16* __restrict__ proj, bf16* __restrict__ heads, const float* __restrict__ hng, float lam, float hscale, const float* __restrict__ nrm, int nblk,
                                              int b, int h, int qb) {
    int tid_ = threadIdx.x; asm volatile("" : "+v"(tid_)); const int tid = tid_, wid = __builtin_amdgcn_readfirstlane(tid >> 6), lane = tid & 63, r32 = lane & 31, hi = lane >> 5;
    const int st = wid >> 2, rg = wid & 3;
    LAS float* al = (LAS float*)(lds + 132096) + wid * 64;
    const size_t rowbase = (size_t)b * T;
    const int Q0 = qb * 128, q0w = Q0 + rg * 32, qpos = q0w + r32;
    const float sl2 = alibi_slope(h, BH) * LOG2E;
    int j_lo, j_hi;
    {   float m0 = 0.f, m1 = 0.f, m2 = 0.f, m3 = 0.f;
        for (int k = lane; k < nblk; k += 64) { const float* p = nrm + (size_t)k * 64 + b * 16 + h * 2; m0 = fmaxf(m0, p[0]); m1 = fmaxf(m1, p[1]); m2 = fmaxf(m2, p[8]); m3 = fmaxf(m3, p[9]); }
#pragma unroll
        for (int o = 1; o < 64; o <<= 1) { m0 = fmaxf(m0, __shfl_xor(m0, o)); m1 = fmaxf(m1, __shfl_xor(m1, o)); m2 = fmaxf(m2, __shfl_xor(m2, o)); m3 = fmaxf(m3, __shfl_xor(m3, o)); }
        const float B = 1.01f * sqrtf(fmaxf(m0 * m2, m1 * m3)) + 0.01f;
        const float dskip = (2.f * B + 42.f) / sl2;
        const float x = ((float)(Q0 - 63) - dskip) * (1.f / 64.f), y = ((float)(Q0 + 127) + dskip) * (1.f / 64.f);
        j_lo = x <= 0.f ? 0 : (int)ceilf(x); j_hi = y >= (float)(T / 64 - 1) ? T / 64 - 1 : (int)floorf(y);
        j_lo = __builtin_amdgcn_readfirstlane(j_lo); j_hi = __builtin_amdgcn_readfirstlane(j_hi);
    }
    bf16x8 qr[4];
    { const bf16* qp = proj + (rowbase + qpos) * INWP + PB_Q + h * 128 + st * 64 + hi * 8;
#pragma unroll
      for (int d0 = 0; d0 < 4; ++d0) qr[d0] = *(const bf16x8*)(qp + d0 * 16); }
    const bf16* ksrc[2]; const bf16* vsrc[2];
#pragma unroll
    for (int i = 0; i < 2; ++i) { int rw, cl; k_slot((i * 8 + wid) * 64 + lane, rw, cl); ksrc[i] = proj + (rowbase + rw) * INWP + PB_K + h * 128 + cl;
        v_slot((i * 8 + wid) * 64 + lane, rw, cl); vsrc[i] = proj + (rowbase + rw) * INWP + PB_V + h * 128 + cl; }
    LAS char* Vb = lds + 65536;
    const int vb0 = lds_addr(Vb) + v_rd_base(lane);
    int ka[4];
#pragma unroll
    for (int d0 = 0; d0 < 4; ++d0) ka[d0] = lds_addr(lds) + KSWZ(r32, st * 128 + (d0 * 16 + hi * 8) * 2);
#define B_ISSUE(tile, buf) do { const size_t ro_ = (size_t)(tile) * 64 * INWP; LAS char* kd_ = lds + (buf) * 16384 + wid * 1024; LAS char* vd_ = Vb + (buf) * 16384 + wid * 1024; \
        glds16(ksrc[0] + ro_, kd_); glds16(ksrc[1] + ro_, kd_ + 8192); glds16(vsrc[0] + ro_, vd_); glds16(vsrc[1] + ro_, vd_ + 8192); } while (0)
#define B_BIAS(P0, P1, J) do { const float dqh_ = (float)(qpos - (J) * 64 - 4 * hi); \
        if ((J) * 64 + 63 < q0w) { const float Lh_ = -sl2 * dqh_;        \
            _Pragma("unroll") for (int r = 0; r < 16; ++r) { const float c0 = (float)((r & 3) + 8 * (r >> 2)); P0[r] = fmaf(sl2, c0, Lh_); P1[r] = fmaf(sl2, c0 + 32.f, Lh_); } } \
        else if ((J) * 64 > q0w + 31) { const float Lh_ = sl2 * dqh_;    \
            _Pragma("unroll") for (int r = 0; r < 16; ++r) { const float c0 = (float)((r & 3) + 8 * (r >> 2)); P0[r] = fmaf(-sl2, c0, Lh_); P1[r] = fmaf(-sl2, c0 + 32.f, Lh_); } } \
        else { _Pragma("unroll") for (int r = 0; r < 16; ++r) { const float c0 = (float)((r & 3) + 8 * (r >> 2)); P0[r] = -sl2 * fabsf(dqh_ - c0); P1[r] = -sl2 * fabsf(dqh_ - 32.f - c0); } } } while (0)
    float l = 0.f; f32x16 o[4];
#pragma unroll
    for (int d = 0; d < 4; ++d)
#pragma unroll
        for (int r = 0; r < 16; ++r) o[d][r] = 0.f;
    const int nt = j_hi - j_lo + 1;
    asm volatile("" :: "v"(qr[0]), "v"(qr[1]), "v"(qr[2]), "v"(qr[3]));
    B_ISSUE(j_lo, 0);
    if (nt > 1) B_ISSUE(j_lo + 1, 1);
    if (nt > 2) B_ISSUE(j_lo + 2, 2);
    f32x16 pc0, pc1;
    if (nt > 2) WAIT_VM(8); else if (nt > 1) WAIT_VM(4); else WAIT_VM(0);
    WG_BAR();
    B_BIAS(pc0, pc1, j_lo);
    qkt_asm<4>(pc0, pc1, ka, 0, qr);
    int bs = 0;
    for (int t = 0; t < nt; ++t) {
        const int j = j_lo + t, bn = (bs + 1) & 3;
        if (t + 1 < nt) { if (t + 2 < nt) WAIT_VM(4); else WAIT_VM(0); }
        WG_BAR();
        if (t + 3 < nt) B_ISSUE(j + 3, (bs + 3) & 3);
        f32x16 pn0, pn1;
        if (t + 1 < nt) { B_BIAS(pn0, pn1, j + 1); qkt_asm<4>(pn0, pn1, ka, bn * 16384, qr); }
        SBAR();
        float ps = 0.f;
#pragma unroll
        for (int r = 0; r < 16; ++r) { pc0[r] = ex2(pc0[r]); ps += pc0[r]; }
#pragma unroll
        for (int r = 0; r < 16; ++r) { pc1[r] = ex2(pc1[r]); ps += pc1[r]; }
        l += ps;
        const bf16x8 pa0 = pk4<0>(pc0), pa1 = pk4<8>(pc0), pa2 = pk4<0>(pc1), pa3 = pk4<8>(pc1);
        SBAR();
        const int vb = vb0 + bs * 16384;
        pv_one<0>(o[0], vb, pa0, pa1, pa2, pa3); pv_one<1>(o[1], vb, pa0, pa1, pa2, pa3); pv_one<2>(o[2], vb, pa0, pa1, pa2, pa3); pv_one<3>(o[3], vb, pa0, pa1, pa2, pa3);
        if (t + 1 < nt) { pc0 = pn0; pc1 = pn1; }
        bs = bn;
    }
#undef B_ISSUE
#undef B_BIAS
    WG_BAR();
    l = xhalf_sum(l);
    row_scale<4>(o, (st ? lam : 1.f) / l, al, r32, hi);
    LAS float* X = (LAS float*)lds + rg * 4096;
    if (st == 1) {
#pragma unroll
        for (int d = 0; d < 4; ++d)
#pragma unroll
            for (int r = 0; r < 16; ++r) X[crow(r, hi) * 128 + d * 32 + r32] = o[d][r];
    }
    __syncthreads();
    if (st == 0) {
        float g[4];
#pragma unroll
        for (int d = 0; d < 4; ++d) g[d] = hng[(AH + h) * 128 + d * 32 + r32] * hscale;
#pragma unroll
        for (int r = 0; r < 16; ++r) { float ss = 0.f;
#pragma unroll
            for (int d = 0; d < 4; ++d) { o[d][r] -= X[crow(r, hi) * 128 + d * 32 + r32]; ss += o[d][r] * o[d][r]; }
            ss += __shfl_xor(ss, 1); ss += __shfl_xor(ss, 2); ss += __shfl_xor(ss, 4); ss += __shfl_xor(ss, 8); ss += __shfl_xor(ss, 16);
            const float rs = 1.0f / sqrtf(ss * (1.f / 128.f) + EPS);
            bf16* hp = heads + (rowbase + qb * 128 + rg * 32 + crow(r, hi)) * DM + (AH + h) * 128 + r32;
#pragma unroll
            for (int d = 0; d < 4; ++d) hp[d * 32] = (bf16)f2bf(o[d][r] * rs * g[d]); }
    }
    __syncthreads();
}

__device__ __forceinline__ void dilattn_unit(LAS char* lds, const bf16* __restrict__ proj, bf16* __restrict__ og, float* __restrict__ lse, int b, int h, int cfg, int rho, int seg) {
    int tid_ = threadIdx.x; asm volatile("" : "+v"(tid_)); const int tid = tid_, wid = __builtin_amdgcn_readfirstlane(tid >> 6), lane = tid & 63, r32 = lane & 31, hi = lane >> 5;
    const int rsh = 2 * cfg, rr = 1 << rsh, nsub = T >> rsh;
    LAS char* Kb = lds; LAS char* Vb = lds + 32768; LAS float* al = (LAS float*)(lds + 65536) + wid * 64;
    const size_t rowbase = (size_t)b * T;
    const int base = seg * 256, qn = base + wid * 32 + r32, qblk = wid >> 1;
    const int qtok = qn * rr + rho;
    bf16x8 qr[8];
    { const bf16* qp = proj + (rowbase + qtok) * INWP + PA_Q + h * 128 + hi * 8;
#pragma unroll
      for (int d0 = 0; d0 < 8; ++d0) qr[d0] = *(const bf16x8*)(qp + d0 * 16); }
    const int sr = tid >> 4, sc = (tid & 15) * 8;
    const bf16* kcol = proj + rowbase * INWP + PA_K + h * 128 + sc;
    const bf16* vcol = proj + rowbase * INWP + PA_V + h * 128 + sc;
    const int vb0 = lds_addr(Vb) + v_rd_base(lane);
    float m = -1e30f, l = 0.f; f32x16 o[4];
#pragma unroll
    for (int d = 0; d < 4; ++d)
#pragma unroll
        for (int r = 0; r < 16; ++r) o[d][r] = 0.f;
    const float C = 0.08838834764831845f * LOG2E, sl2 = alibi_slope(h, AH) * LOG2E * (float)rr;
    Stg2 sk, sv;
#define DIL_LOAD(kt) do { int k0 = base + 64 * ((kt) - 1) + sr, k1 = k0 + 32; k0 = k0 < 0 ? 0 : (k0 >= nsub ? nsub - 1 : k0); k1 = k1 < 0 ? 0 : (k1 >= nsub ? nsub - 1 : k1); \
        const size_t o0 = (size_t)(k0 * rr + rho) * INWP, o1 = (size_t)(k1 * rr + rho) * INWP; \
        sk.a = *(const bf16x8*)(kcol + o0); sk.b = *(const bf16x8*)(kcol + o1); sv.a = *(const bf16x8*)(vcol + o0); sv.b = *(const bf16x8*)(vcol + o1); } while (0)
    DIL_LOAD(0);
    stg_store_k(Kb, sk, sr, sc); stg_store_v(Vb, sv, sr, sc);
    __syncthreads();
    for (int kt = 0; kt < 6; ++kt) {
        const int bs = kt & 1;
        if (kt + 1 < 6) DIL_LOAD(kt + 1);
        if (kt >= qblk && kt <= qblk + 2) {
            f32x16 p0, p1;
            qkt<8, true>(p0, p1, Kb + bs * 16384, qr, 0, r32, hi);
            const int kn0 = base + 64 * (kt - 1);
            const float dqh = (float)(qn - kn0 - 4 * hi), fq = (float)qn, fqn = (float)(qn - nsub);
#pragma unroll
            for (int r = 0; r < 16; ++r) { const float c0 = (float)((r & 3) + 8 * (r >> 2));
                const float d0v = dqh - c0, d1v = dqh - 32.f - c0;
                const bool v0 = fabsf(d0v) <= 64.f && d0v <= fq && d0v > fqn, v1 = fabsf(d1v) <= 64.f && d1v <= fq && d1v > fqn;
                p0[r] = v0 ? fmaf(p0[r], C, -sl2 * fabsf(d0v)) : -INFINITY; p1[r] = v1 ? fmaf(p1[r], C, -sl2 * fabsf(d1v)) : -INFINITY; }
            const float alpha = sm_update(p0, p1, m, l);
            if (__any(alpha < 1.f)) row_scale<4>(o, alpha, al, r32, hi);
            const bf16x8 pa0 = pk4<0>(p0), pa1 = pk4<8>(p0), pa2 = pk4<0>(p1), pa3 = pk4<8>(p1);
            const int vb = vb0 + bs * 16384;
            pv_one<0>(o[0], vb, pa0, pa1, pa2, pa3); pv_one<1>(o[1], vb, pa0, pa1, pa2, pa3); pv_one<2>(o[2], vb, pa0, pa1, pa2, pa3); pv_one<3>(o[3], vb, pa0, pa1, pa2, pa3);
        }
        if (kt + 1 < 6) { stg_store_k(Kb + (bs ^ 1) * 16384, sk, sr, sc); stg_store_v(Vb + (bs ^ 1) * 16384, sv, sr, sc); }
        __syncthreads();
    }
#undef DIL_LOAD
    row_scale<4>(o, 1.f / l, al, r32, hi);
    if (hi == 0) lse[((size_t)cfg * M + rowbase + qtok) * AH + h] = (m + __log2f(l)) * LN2;
    bf16* ob = og + ((size_t)cfg * M + rowbase) * (AH * HD) + h * 128 + r32;
#pragma unroll
    for (int r = 0; r < 16; ++r) { const int tok = (base + wid * 32 + crow(r, hi)) * rr + rho;
#pragma unroll
        for (int d = 0; d < 4; ++d) ob[(size_t)tok * (AH * HD) + d * 32] = (bf16)f2bf(o[d][r]); }
}

__device__ __forceinline__ void xattn_unit(LAS char* lds, const bf16* __restrict__ xq, const bf16* __restrict__ kv, bf16* __restrict__ xa, int b, int h, int qb) {
    int tid_ = threadIdx.x; asm volatile("" : "+v"(tid_)); const int tid = tid_, wid = __builtin_amdgcn_readfirstlane(tid >> 6), lane = tid & 63, r32 = lane & 31, hi = lane >> 5;
    LAS char* Kb = lds; LAS char* Vb = lds + 32768; LAS float* al = (LAS float*)(lds + 65536) + wid * 64;
    const size_t row = (size_t)b * T + qb * 256 + wid * 32 + r32;
    const int sr = tid >> 4, sc = (tid & 15) * 8;
    const bf16* kbase = kv + ((size_t)b * MEML + sr) * (2 * DM) + h * XHD + sc;
    const bf16* vbase = kbase + DM;
    const bf16* qp = xq + row * DM + h * XHD + hi * 8;
    f32x16 s[4][2];
#pragma unroll
    for (int t = 0; t < 4; ++t)
#pragma unroll
        for (int r = 0; r < 16; ++r) { s[t][0][r] = 0.f; s[t][1][r] = 0.f; }
    Stg2 sg;
    sg.a = *(const bf16x8*)(kbase); sg.b = *(const bf16x8*)(kbase + (size_t)32 * 2 * DM);
    stg_store_k(Kb, sg, sr, sc);
    __syncthreads();
    bf16x8 qr[8];
#pragma unroll
    for (int i = 0; i < 16; ++i) { const int dc = i >> 2, kt = i & 3;
        if (kt == 0) {
#pragma unroll
            for (int d0 = 0; d0 < 8; ++d0) qr[d0] = *(const bf16x8*)(qp + dc * 128 + d0 * 16); }
        if (i + 1 < 16) { const int dc2 = (i + 1) >> 2, kt2 = (i + 1) & 3; const bf16* p = kbase + (size_t)(kt2 * 64) * 2 * DM + dc2 * 128; sg.a = *(const bf16x8*)p; sg.b = *(const bf16x8*)(p + (size_t)32 * 2 * DM); }
        qkt<8, false>(s[kt][0], s[kt][1], Kb + (i & 1) * 16384, qr, 0, r32, hi);
        if (i + 1 < 16) stg_store_k(Kb + ((i + 1) & 1) * 16384, sg, sr, sc);
        __syncthreads();
    }
    float mx = s[0][0][0];
#pragma unroll
    for (int t = 0; t < 4; ++t)
#pragma unroll
        for (int r = 0; r < 16; ++r) { mx = fmaxf(mx, s[t][0][r]); mx = fmaxf(mx, s[t][1][r]); }
    mx = xhalf_max(mx);
    float ps = 0.f;
#pragma unroll
    for (int t = 0; t < 4; ++t)
#pragma unroll
        for (int r = 0; r < 16; ++r) { s[t][0][r] = ex2(s[t][0][r] - mx); ps += s[t][0][r]; s[t][1][r] = ex2(s[t][1][r] - mx); ps += s[t][1][r]; }
    ps = xhalf_sum(ps);
    bf16x8 pa[4][4];
#pragma unroll
    for (int t = 0; t < 4; ++t) { pa[t][0] = pk4<0>(s[t][0]); pa[t][1] = pk4<8>(s[t][0]); pa[t][2] = pk4<0>(s[t][1]); pa[t][3] = pk4<8>(s[t][1]); }
    if (hi == 0) al[r32] = 1.f / ps;
    LDS_WAIT();
    float rl[16];
#pragma unroll
    for (int r = 0; r < 16; ++r) rl[r] = al[crow(r, hi)];
    const int vb0 = lds_addr(Vb) + v_rd_base(lane);
    sg.a = *(const bf16x8*)(vbase); sg.b = *(const bf16x8*)(vbase + (size_t)32 * 2 * DM);
    stg_store_v(Vb, sg, sr, sc);
    __syncthreads();
    f32x16 o[4];
#pragma unroll
    for (int i = 0; i < 16; ++i) { const int vc = i >> 2, kt = i & 3;
        if (kt == 0) {
#pragma unroll
            for (int d = 0; d < 4; ++d)
#pragma unroll
                for (int r = 0; r < 16; ++r) o[d][r] = 0.f; }
        if (i + 1 < 16) { const int vc2 = (i + 1) >> 2, kt2 = (i + 1) & 3; const bf16* p = vbase + (size_t)(kt2 * 64) * 2 * DM + vc2 * 128; sg.a = *(const bf16x8*)p; sg.b = *(const bf16x8*)(p + (size_t)32 * 2 * DM); }
        const int vb = vb0 + (i & 1) * 16384;
        pv_one<0>(o[0], vb, pa[kt][0], pa[kt][1], pa[kt][2], pa[kt][3]); pv_one<1>(o[1], vb, pa[kt][0], pa[kt][1], pa[kt][2], pa[kt][3]);
        pv_one<2>(o[2], vb, pa[kt][0], pa[kt][1], pa[kt][2], pa[kt][3]); pv_one<3>(o[3], vb, pa[kt][0], pa[kt][1], pa[kt][2], pa[kt][3]);
        if (kt == 3) {
            bf16* op = xa + ((size_t)b * T + qb * 256 + wid * 32) * DM + h * XHD + vc * 128 + r32;
#pragma unroll
            for (int r = 0; r < 16; ++r)
#pragma unroll
                for (int d = 0; d < 4; ++d) op[(size_t)crow(r, hi) * DM + d * 32] = (bf16)f2bf(o[d][r] * rl[r]);
        }
        if (i + 1 < 16) stg_store_v(Vb + ((i + 1) & 1) * 16384, sg, sr, sc);
        __syncthreads();
    }
}

__device__ __forceinline__ void mlstm_dc_unit(LAS char* lds, const bf16* __restrict__ cqk, const bf16* __restrict__ proj, const float* __restrict__ GA, const LAS float* ML,
                                              bf16* __restrict__ dC, float* __restrict__ dn, int b, int h, int c) {
    int tid_ = threadIdx.x; asm volatile("" : "+v"(tid_)); const int tid = tid_, wid = __builtin_amdgcn_readfirstlane(tid >> 6), lane = tid & 63, r32 = lane & 31, hi = lane >> 5;
    const int bh = b * CH + h;
    LAS char* KF = lds; LAS char* KB = lds + 32768; LAS char* VV = lds + 65536;
    const int sr = tid >> 4, sc = (tid & 15) * 8;
    const float mlf = ML[(0 * 24 + bh) * NCH + c], mlb = ML[(1 * 24 + bh) * NCH + c];
#pragma unroll
    for (int q = 0; q < 4; ++q) { const int s = q * 32 + sr; const size_t m = (size_t)b * T + c * LC + s;
        const bf16x8 kk = *(const bf16x8*)(cqk + m * 1536 + 768 + h * 128 + sc);
        const bf16x8 vv = *(const bf16x8*)(proj + m * INWP + PC_V + h * 128 + sc);
        const float gwf = ex2((GA[(size_t)(0 * 24 + bh) * T + c * LC + s] - mlf) * LOG2E), gwb = ex2((GA[(size_t)(1 * 24 + bh) * T + c * LC + s] - mlb) * LOG2E);
        const int off = (q >> 1) * 16384 + v_st((q & 1) * 32 + sr, sc);
        *(LAS bf16x8*)(KF + off) = scale8(kk, gwf); *(LAS bf16x8*)(KB + off) = scale8(kk, gwb); *(LAS bf16x8*)(VV + off) = vv; }
    __syncthreads();
    const int dir = wid >> 2, dk0 = wid & 3;
    const int va = lds_addr(dir ? KB : KF) + v_rd_base(lane) + dk0 * 512, vv0 = lds_addr(VV) + v_rd_base(lane);
    f32x16 acc[4], accn;
#pragma unroll
    for (int r = 0; r < 16; ++r) { acc[0][r] = 0.f; acc[1][r] = 0.f; acc[2][r] = 0.f; acc[3][r] = 0.f; accn[r] = 0.f; }
    const bf16x8 ones = {0x3F80, 0x3F80, 0x3F80, 0x3F80, 0x3F80, 0x3F80, 0x3F80, 0x3F80};
#define DC_STEP(t, ks) do { const s16x4 al_ = tr_read<(t) * 16384 + v_rd_off(0, ks, 0)>(va), ah_ = tr_read<(t) * 16384 + v_rd_off(0, ks, 1)>(va); \
        const s16x4 b0l = tr_read<(t) * 16384 + v_rd_off(0, ks, 0)>(vv0), b0h = tr_read<(t) * 16384 + v_rd_off(0, ks, 1)>(vv0), b1l = tr_read<(t) * 16384 + v_rd_off(1, ks, 0)>(vv0), b1h = tr_read<(t) * 16384 + v_rd_off(1, ks, 1)>(vv0); \
        const s16x4 b2l = tr_read<(t) * 16384 + v_rd_off(2, ks, 0)>(vv0), b2h = tr_read<(t) * 16384 + v_rd_off(2, ks, 1)>(vv0), b3l = tr_read<(t) * 16384 + v_rd_off(3, ks, 0)>(vv0), b3h = tr_read<(t) * 16384 + v_rd_off(3, ks, 1)>(vv0); \
        asm volatile("s_waitcnt lgkmcnt(0)" ::: "memory"); SBAR(); const bf16x8 A_ = PK8(al_, ah_); \
        acc[0] = __builtin_amdgcn_mfma_f32_32x32x16_bf16(A_, PK8(b0l, b0h), acc[0], 0, 0, 0); acc[1] = __builtin_amdgcn_mfma_f32_32x32x16_bf16(A_, PK8(b1l, b1h), acc[1], 0, 0, 0); \
        acc[2] = __builtin_amdgcn_mfma_f32_32x32x16_bf16(A_, PK8(b2l, b2h), acc[2], 0, 0, 0); acc[3] = __builtin_amdgcn_mfma_f32_32x32x16_bf16(A_, PK8(b3l, b3h), acc[3], 0, 0, 0); \
        accn = __builtin_amdgcn_mfma_f32_32x32x16_bf16(A_, ones, accn, 0, 0, 0); } while (0)
    DC_STEP(0, 0); DC_STEP(0, 1); DC_STEP(0, 2); DC_STEP(0, 3); DC_STEP(1, 0); DC_STEP(1, 1); DC_STEP(1, 2); DC_STEP(1, 3);
#undef DC_STEP
    bf16* dp = dC + ((size_t)(dir * 24 + bh) * NCH + c) * (LC * HD) + (size_t)(dk0 * 32) * HD + r32;
#pragma unroll
    for (int r = 0; r < 16; ++r)
#pragma unroll
        for (int d = 0; d < 4; ++d) dp[(size_t)crow(r, hi) * HD + d * 32] = (bf16)f2bf(acc[d][r]);
    if (r32 == 0) { float* np = dn + ((size_t)(dir * 24 + bh) * NCH + c) * HD + dk0 * 32;
#pragma unroll
        for (int r = 0; r < 16; ++r) np[crow(r, hi)] = accn[r]; }
    __syncthreads();
}

constexpr int SM_OFF = 132096;
__device__ __forceinline__ void mlstm_out_unit(LAS char* lds, const bf16* __restrict__ cqk, const bf16* __restrict__ proj, const float* __restrict__ GA, const float* __restrict__ GM, const float* __restrict__ GB,
                                               const float* __restrict__ MS, const bf16* __restrict__ Cst, const float* __restrict__ nst, bf16* __restrict__ heads, const float* __restrict__ hng, int b, int h, int c) {
    int tid_ = threadIdx.x; asm volatile("" : "+v"(tid_)); const int tid = tid_, wid = __builtin_amdgcn_readfirstlane(tid >> 6), lane = tid & 63, r32 = lane & 31, hi = lane >> 5;
    const int bh = b * CH + h, rg = wid & 3, ch = wid >> 2;
    LAS char* KK = lds; LAS char* VV = lds + 32768; LAS char* CF = lds + 65536; LAS char* CB = lds + 98304;
    LAS float* SM = (LAS float*)(lds + SM_OFF);
    const int sr = tid >> 4, sc = (tid & 15) * 8;
    const size_t m0 = (size_t)b * T + c * LC;
    const size_t seqf = (size_t)(0 * 24 + bh), seqb = (size_t)(1 * 24 + bh);
    const bf16* cfp = Cst + (seqf * NCH + c) * (LC * HD); const bf16* cbp = Cst + (seqb * NCH + c) * (LC * HD);
#pragma unroll
    for (int q = 0; q < 4; ++q) { const int s = q * 32 + sr;
        const bf16x8 kk = *(const bf16x8*)(cqk + (m0 + s) * 1536 + 768 + h * 128 + sc);
        const bf16x8 vv = *(const bf16x8*)(proj + (m0 + s) * INWP + PC_V + h * 128 + sc);
        const bf16x8 cf = *(const bf16x8*)(cfp + (size_t)s * HD + sc);
        const bf16x8 cb = *(const bf16x8*)(cbp + (size_t)s * HD + sc);
        *(LAS bf16x8*)(KK + (q >> 1) * 16384 + KSWZ((q & 1) * 32 + sr, sc * 2)) = kk;
        const int off = (q >> 1) * 16384 + v_st((q & 1) * 32 + sr, sc);
        *(LAS bf16x8*)(VV + off) = vv; *(LAS bf16x8*)(CF + off) = cf; *(LAS bf16x8*)(CB + off) = cb; }
    if (tid < 128) { SM[tid] = GA[seqf * T + c * LC + tid] * LOG2E; SM[128 + tid] = GA[seqb * T + c * LC + tid] * LOG2E; SM[256 + tid] = nst[(seqf * NCH + c) * HD + tid]; SM[384 + tid] = nst[(seqb * NCH + c) * HD + tid]; }
    const int i = rg * 32 + r32;
    bf16x8 qr[8];
    { const bf16* qp = cqk + (m0 + i) * 1536 + h * 128 + hi * 8;
#pragma unroll
      for (int d0 = 0; d0 < 8; ++d0) qr[d0] = *(const bf16x8*)(qp + d0 * 16); }
    const float msf = MS[seqf * NCH + c], msb = MS[seqb * NCH + c];
    const float Mf = fmaxf(msf, GM[seqf * T + c * LC + i]), Mb = fmaxf(msb, GM[seqb * T + c * LC + i]), bcf = GB[seqf * T + c * LC + i], bcb = GB[seqb * T + c * LC + i];
    __syncthreads();
    f32x16 p[2][2];
    qkt<8, true>(p[0][0], p[0][1], KK, qr, 0, r32, hi);
    qkt<8, true>(p[1][0], p[1][1], KK + 16384, qr, 0, r32, hi);
    float qnf = 0.f, qnb = 0.f;
#pragma unroll
    for (int d0 = 0; d0 < 8; ++d0) {
#pragma unroll
        for (int j = 0; j < 8; ++j) { const float qv = bf2f((unsigned short)qr[d0][j]); const int dim = d0 * 16 + hi * 8 + j; qnf = fmaf(qv, SM[256 + dim], qnf); qnb = fmaf(qv, SM[384 + dim], qnb); }
        SBAR(); }
    qnf = xhalf_sum(qnf); qnb = xhalf_sum(qnb);
    const float MfL = Mf * LOG2E, MbL = Mb * LOG2E, tb = (float)(4 * hi - i);
    float rsf = 0.f, rsb = 0.f;
#pragma unroll
    for (int t = 0; t < 2; ++t)
#pragma unroll
        for (int hf = 0; hf < 2; ++hf) {
#pragma unroll
            for (int r = 0; r < 16; ++r) { const int jc = t * 64 + hf * 32 + (r & 3) + 8 * (r >> 2); const float tt = tb + (float)jc;
                const LAS float* sj = SM + jc + 4 * hi;
                const float ef = ex2(fmaf(fmaxf(tt, 0.f), -1e30f, sj[0] - MfL)), eb = ex2(fmaf(fmaxf(-tt, 0.f), -1e30f, sj[128] - MbL));
                rsf = fmaf(p[t][hf][r], ef, rsf); rsb = fmaf(p[t][hf][r], eb, rsb); }
            SBAR(); }
    rsf = xhalf_sum(rsf); rsb = xhalf_sum(rsb);
    const float iwf = ex2((msf - Mf) * LOG2E), iwb = ex2((msb - Mb) * LOG2E);
    const float denf = fmaf(iwf, qnf, rsf), denb = fmaf(iwb, qnb, rsb);
    const float rf = 1.f / fmaxf(fabsf(denf), ex2((-bcf - Mf) * LOG2E)), rb = 1.f / fmaxf(fabsf(denb), ex2((-bcb - Mb) * LOG2E));
    float tb2 = tb; asm volatile("" : "+v"(tb2));
#pragma unroll
    for (int t = 0; t < 2; ++t)
#pragma unroll
        for (int hf = 0; hf < 2; ++hf) {
#pragma unroll
            for (int r = 0; r < 16; ++r) { const int jc = t * 64 + hf * 32 + (r & 3) + 8 * (r >> 2); const float tt = tb2 + (float)jc;
                const LAS float* sj = SM + jc + 4 * hi;
                const float ef = ex2(fmaf(fmaxf(tt, 0.f), -1e30f, sj[0] - MfL)), eb = ex2(fmaf(fmaxf(-tt, 0.f), -1e30f, sj[128] - MbL));
                p[t][hf][r] *= fmaf(ef, rf, eb * rb); }
            SBAR(); }
    const float sf = iwf * rf, sb = iwb * rb;
    f32x16 o[2];
#pragma unroll
    for (int r = 0; r < 16; ++r) { o[0][r] = 0.f; o[1][r] = 0.f; }
    const int vbv = lds_addr(VV) + v_rd_base(lane) + ch * 1024, vbf = lds_addr(CF) + v_rd_base(lane) + ch * 1024, vbb = lds_addr(CB) + v_rd_base(lane) + ch * 1024;
    {   const bf16x8 a0 = pk4<0>(p[0][0]), a1 = pk4<8>(p[0][0]), a2 = pk4<0>(p[0][1]), a3 = pk4<8>(p[0][1]);
        pv_one<0>(o[0], vbv, a0, a1, a2, a3); pv_one<1>(o[1], vbv, a0, a1, a2, a3); }
    {   const bf16x8 a0 = pk4<0>(p[1][0]), a1 = pk4<8>(p[1][0]), a2 = pk4<0>(p[1][1]), a3 = pk4<8>(p[1][1]);
        pv_one<0>(o[0], vbv + 16384, a0, a1, a2, a3); pv_one<1>(o[1], vbv + 16384, a0, a1, a2, a3); }
    {   const bf16x8 a0 = scale8(qr[0], sf), a1 = scale8(qr[1], sf), a2 = scale8(qr[2], sf), a3 = scale8(qr[3], sf);
        pv_one<0>(o[0], vbf, a0, a1, a2, a3); pv_one<1>(o[1], vbf, a0, a1, a2, a3); }
    {   const bf16x8 a0 = scale8(qr[4], sf), a1 = scale8(qr[5], sf), a2 = scale8(qr[6], sf), a3 = scale8(qr[7], sf);
        pv_one<0>(o[0], vbf + 16384, a0, a1, a2, a3); pv_one<1>(o[1], vbf + 16384, a0, a1, a2, a3); }
    {   const bf16x8 a0 = scale8(qr[0], sb), a1 = scale8(qr[1], sb), a2 = scale8(qr[2], sb), a3 = scale8(qr[3], sb);
        pv_one<0>(o[0], vbb, a0, a1, a2, a3); pv_one<1>(o[1], vbb, a0, a1, a2, a3); }
    {   const bf16x8 a0 = scale8(qr[4], sb), a1 = scale8(qr[5], sb), a2 = scale8(qr[6], sb), a3 = scale8(qr[7], sb);
        pv_one<0>(o[0], vbb + 16384, a0, a1, a2, a3); pv_one<1>(o[1], vbb + 16384, a0, a1, a2, a3); }
    const int col0 = ch * 64 + r32;
    float ss[16];
#pragma unroll
    for (int r = 0; r < 16; ++r) { const bf16* gp = proj + (m0 + rg * 32 + crow(r, hi)) * INWP + PC_O + h * 128 + col0; float s2 = 0.f;
#pragma unroll
        for (int d = 0; d < 2; ++d) { const float gate = bf2f(gp[d * 32]); const float v = o[d][r] / (1.f + __expf(-gate)); o[d][r] = v; s2 = fmaf(v, v, s2); }
        s2 += __shfl_xor(s2, 1); s2 += __shfl_xor(s2, 2); s2 += __shfl_xor(s2, 4); s2 += __shfl_xor(s2, 8); s2 += __shfl_xor(s2, 16);
        ss[r] = s2; if (r32 == 0) SM[512 + ch * 128 + rg * 32 + crow(r, hi)] = s2; }
    __syncthreads();
    const float g0 = hng[(AH + BH + h) * 128 + col0], g1 = hng[(AH + BH + h) * 128 + col0 + 32];
#pragma unroll
    for (int r = 0; r < 16; ++r) { const float tot = ss[r] + SM[512 + (ch ^ 1) * 128 + rg * 32 + crow(r, hi)]; const float rs = 1.0f / sqrtf(tot * (1.f / 128.f) + EPS);
        bf16* hp = heads + (m0 + rg * 32 + crow(r, hi)) * DM + (AH + BH + h) * 128 + col0;
        hp[0] = (bf16)f2bf(o[0][r] * rs * g0); hp[32] = (bf16)f2bf(o[1][r] * rs * g1); }
    __syncthreads();
}

constexpr size_t MiB = 1u << 20;
constexpr size_t WS_CTL = 0, CTL_ZERO_BYTES = 1 * MiB;
constexpr size_t WS_GATES = 1 * MiB;
constexpr size_t GSEQ_BYTES = (size_t)2 * 24 * T * 4;
constexpr size_t WS_GA = 3 * MiB, WS_GM = WS_GA + GSEQ_BYTES, WS_GB = WS_GM + GSEQ_BYTES;
constexpr size_t WS_MS = WS_GB + GSEQ_BYTES, WS_ML = WS_MS + 8192, WS_BL = WS_ML + 8192, WS_AL = WS_BL + 8192, WS_NRM = WS_AL + 8192;
constexpr size_t WS_DN = 6 * MiB;
constexpr size_t WS_LSE = 7 * MiB;
constexpr size_t WS_MEMB = 9 * MiB;
constexpr size_t WS_KV = 13 * MiB;
constexpr size_t WS_W = 22 * MiB;
constexpr size_t W_IN = 0, W_OUT = 28 * MiB, W_XQ = 36 * MiB, W_XKV = 44 * MiB, W_XO = 60 * MiB, W_UP = 68 * MiB, W_DOWN = 100 * MiB;
constexpr size_t WS_ACT0 = 154 * MiB;
constexpr size_t WS_ACT1 = 218 * MiB;
constexpr size_t WS_PROJ = 282 * MiB;
constexpr size_t WS_XRES = 538 * MiB;
constexpr size_t OUT_OG = 0, OUT_DC = 72 * MiB;
constexpr size_t WS_SSP = 626 * MiB;
constexpr size_t WS_END = 628 * MiB;
static_assert(WS_KV + (size_t)1024 * 4096 * 2 <= WS_W && WS_W + 132 * MiB <= WS_ACT0 && WS_PROJ + (size_t)M * INWP * 2 <= WS_XRES && WS_PROJ + (size_t)M * DFF * 2 <= WS_XRES && WS_XRES + (size_t)M * DM * 2 <= WS_SSP, "d_ws map");
static_assert(OUT_OG + (size_t)3 * M * 768 * 2 <= OUT_DC && OUT_DC + (size_t)2 * 24 * 32 * 128 * 128 * 2 <= (size_t)M * DM * 4 && WS_NRM + 65536 <= WS_DN && WS_LSE + (size_t)3 * M * 6 * 4 <= WS_MEMB, "d_ws map 2");
constexpr int CW_TMO = 0, CW_BAR = 4096;
constexpr int RING_OFF = 0, RING_BYTES = 131072, LDSCTL_OFF = RING_BYTES, MISC_OFF = LDSCTL_OFF + 320, LDS_BYTES = 151552;
constexpr int TBL_OFF = 136192;
constexpr int NWAVES = 8;
constexpr int NPH = 15, NPHT = DEPTH * NPH + 1;

#define XB_TMO      128
#define XB_XCNT(j)  (256  + 64 * (j))
#define XB_XSUB(j)  (1280 + 64 * (j))
#define XB_XGEN(j)  (2304 + 64 * (j))
#define XB_TOP      3328
#define XB_TOPGEN   3392
#define XCD_BAR_WORDS 3456
#define XB_SPIN_CAP (1u << 18)

__device__ __forceinline__ unsigned xb_ld(unsigned* p)              { return __hip_atomic_load(p, __ATOMIC_RELAXED, __HIP_MEMORY_SCOPE_AGENT); }
__device__ __forceinline__ unsigned xb_add(unsigned* p, unsigned v) { return __hip_atomic_fetch_add(p, v, __ATOMIC_RELAXED, __HIP_MEMORY_SCOPE_AGENT); }
__device__ __forceinline__ unsigned xb_xcc_id() { return (unsigned)__builtin_amdgcn_s_getreg((3 << 11) | 20) & 0xFu; }
#define XB_SPIN(cond, bar) do { unsigned _sp = 0; while (cond) { __builtin_amdgcn_s_sleep(1); \
    if ((++_sp & 255u) == 0u) { if (xb_ld(&(bar)[XB_TMO])) break; if (_sp > XB_SPIN_CAP) { atomicAdd(&(bar)[XB_TMO], 1u); break; } } } } while (0)

struct XcdBarrier {
    unsigned* bar; unsigned x;
    volatile LAS unsigned* st;
};

__device__ __forceinline__ XcdBarrier xcd_barrier_post(unsigned* bar, volatile LAS unsigned* st) {
    XcdBarrier b; b.bar = bar; b.x = xb_xcc_id(); b.st = st;
    if (threadIdx.x == 0) (void)xb_add(&bar[XB_XCNT(b.x)], 1u);
    return b;
}
__device__ __forceinline__ void xcd_barrier_complete(unsigned* bar, unsigned x, unsigned& nloc, unsigned& nx) {
    const unsigned G = gridDim.x * gridDim.y * gridDim.z;
    unsigned sum, cnt, mine, sp = 0u;
    for (;;) {
        sum = 0u; cnt = 0u; mine = 0u;
#pragma unroll
        for (unsigned j = 0; j < 16; ++j) { const unsigned c = xb_ld(&bar[XB_XCNT(j)]); sum += c; cnt += (c > 0u) ? 1u : 0u; mine = (j == x) ? c : mine; }
        if (sum == G) break;
        __builtin_amdgcn_s_sleep(1);
        if ((++sp & 255u) == 0u) { if (xb_ld(&bar[XB_TMO])) break; if (sp > XB_SPIN_CAP) { atomicAdd(&bar[XB_TMO], 1u); break; } }
    }
    nloc = mine > 0u ? mine : 1u; nx = cnt > 0u ? cnt : 1u;
}

__device__ __forceinline__ void xcd_barrier(const XcdBarrier& b) {
    asm volatile("s_waitcnt vmcnt(0)" ::: "memory");
    __syncthreads();
    if (threadIdx.x == 0) {
        unsigned* bar = b.bar;
        __builtin_amdgcn_s_waitcnt(0);
        unsigned nloc = b.st[0], nx = b.st[1];
        if (nloc == 0u) { xcd_barrier_complete(bar, b.x, nloc, nx); b.st[0] = nloc; b.st[1] = nx; }
        const unsigned old = xb_add(&bar[XB_XSUB(b.x)], 1u);
        const unsigned gen = old / nloc;
        if (old + 1u == (gen + 1u) * nloc) {
            __builtin_amdgcn_fence(__ATOMIC_RELEASE, "agent");
            asm volatile("s_waitcnt vmcnt(0)" ::: "memory");
            const unsigned og = xb_add(&bar[XB_TOP], 1u);
            const unsigned tg = og / nx;
            if (og + 1u == (tg + 1u) * nx) xb_add(&bar[XB_TOPGEN], 1u);
            else XB_SPIN(xb_ld(&bar[XB_TOPGEN]) == tg, bar);
            __builtin_amdgcn_fence(__ATOMIC_ACQUIRE, "agent");
            xb_add(&bar[XB_XGEN(b.x)], 1u);
            asm volatile("s_waitcnt vmcnt(0)" ::: "memory");
        } else {
            XB_SPIN(xb_ld(&bar[XB_XGEN(b.x)]) == gen, bar);
            __builtin_amdgcn_fence(__ATOMIC_ACQUIRE, "agent");
            asm volatile("s_waitcnt vmcnt(0)" ::: "memory");
        }
    }
    __syncthreads();
}

__device__ __forceinline__ float wave_sum(float v) {
#pragma unroll
    for (int o = 1; o < 64; o <<= 1) v += __shfl_xor(v, o);
    return v;
}
__device__ __forceinline__ float wave_incl_sum(float x, int lane) {
#pragma unroll
    for (int o = 1; o < 64; o <<= 1) { const float v = __shfl_up(x, o); if (lane >= o) x += v; }
    return x;
}
__device__ __forceinline__ float wave_incl_max(float x, int lane) {
#pragma unroll
    for (int o = 1; o < 64; o <<= 1) { const float v = __shfl_up(x, o); if (lane >= o) x = fmaxf(x, v); }
    return x;
}
__device__ __forceinline__ void tr_load(float (&v)[32], const float* __restrict__ W, int N, int nblk, int r, int lane) {
    const int kb = r / nblk, nb = r % nblk, k0 = 64 * kb, n0 = 32 * nb;
    const int nn = n0 + (lane & 31); const bool ok = nn < N;
    const float* p = W + (size_t)(k0 + (lane >> 5)) * N + nn;
#pragma unroll
    for (int i = 0; i < 32; ++i) v[i] = ok ? p[(size_t)(2 * i) * N] : 0.f;
}
__device__ __forceinline__ void tr_store(const float (&v)[32], bf16* __restrict__ WT, const float* __restrict__ gain, int K, int nblk, int r, LAS float* scr, int lane, int cs_lo, int cs_hi, float cs_val) {
    const int kb = r / nblk, nb = r % nblk, k0 = 64 * kb, n0 = 32 * nb;
#pragma unroll
    for (int i = 0; i < 32; ++i) scr[(2 * i + (lane >> 5)) * 33 + (lane & 31)] = v[i];
    LDS_WAIT(); asm volatile("" ::: "memory");
    const int c = lane & 7;
    float g[8];
#pragma unroll
    for (int e = 0; e < 8; ++e) g[e] = gain ? gain[k0 + 8 * c + e] : 1.f;
#pragma unroll
    for (int j = 0; j < 4; ++j) { const int n = (lane >> 3) + 8 * j; const LAS float* s = scr + (8 * c) * 33 + n; const float cs = (n0 + n >= cs_lo && n0 + n < cs_hi) ? cs_val : 1.f;
        v4u o; o.x = pk2(s[0 * 33] * g[0] * cs, s[1 * 33] * g[1] * cs); o.y = pk2(s[2 * 33] * g[2] * cs, s[3 * 33] * g[3] * cs); o.z = pk2(s[4 * 33] * g[4] * cs, s[5 * 33] * g[5] * cs); o.w = pk2(s[6 * 33] * g[6] * cs, s[7 * 33] * g[7] * cs);
        *(v4u*)(WT + (size_t)(n0 + n) * K + k0 + 8 * c) = o; }
    LDS_WAIT(); asm volatile("" ::: "memory");
}
__device__ __forceinline__ void rownorm_bf16(const float* __restrict__ X, bf16* __restrict__ O, int nrows, int gw, int NGW, int lane) {
    for (int m = gw; m < nrows; m += NGW) {
        const f32x4* xr = (const f32x4*)(X + (size_t)m * DM) + lane; f32x4 v[8]; float s = 0.f;
#pragma unroll
        for (int j = 0; j < 8; ++j) { v[j] = xr[64 * j]; s += (v[j].x * v[j].x + v[j].y * v[j].y) + (v[j].z * v[j].z + v[j].w * v[j].w); }
        const float rs = 1.0f / sqrtf(wave_sum(s) * (1.f / DM) + EPS);
        unsigned long long* o8 = (unsigned long long*)(O + (size_t)m * DM) + lane;
#pragma unroll
        for (int j = 0; j < 8; ++j) o8[64 * j] = (unsigned long long)pk2(v[j].x * rs, v[j].y * rs) | ((unsigned long long)pk2(v[j].z * rs, v[j].w * rs) << 32);
    }
}
__device__ __forceinline__ float log_sigmoid(float x) { return fminf(x, 0.f) - log1pf(expf(-fabsf(x))); }

struct Args { const float* in[18]; float* out; unsigned char* ws; int ph_lo, ph_hi; };

#ifndef PG8_SP2
#define PG8_SP2 true
#endif
#ifndef PG8_ALIGN
#define PG8_ALIGN true
#endif

__global__ void __launch_bounds__(NWAVES * 64, 2) enc_fwd(Args args) {
    extern __shared__ __attribute__((aligned(16))) unsigned char lds_raw[];
    LAS unsigned char* lds = (LAS unsigned char*)lds_raw;
    volatile LAS unsigned* MISC = (volatile LAS unsigned*)(lds + MISC_OFF);
    const int G = gridDim.x, bx = blockIdx.x;
    const int vcu = (G % 8 == 0) ? (bx % 8) * (G / 8) + bx / 8 : bx;
    const int NGW = G * NWAVES; const size_t NTH = (size_t)G * NWAVES * 64;
#define PH_IDS int ptid_ = threadIdx.x; asm volatile("" : "+v"(ptid_)); const int tid = ptid_, lane = tid & 63, wave = __builtin_amdgcn_readfirstlane(tid >> 6); \
    const int gw = vcu * NWAVES + wave; const size_t gt = (size_t)bx * (NWAVES * 64) + tid; (void)lane; (void)gw; (void)gt;
    unsigned char* ws = args.ws;
    gu32* ctl = (gu32*)(ws + WS_CTL);
    for (int u = threadIdx.x; u < (LDS_BYTES - LDSCTL_OFF) / 4; u += NWAVES * 64) ((LAS unsigned*)(lds + LDSCTL_OFF))[u] = 0u;
    __syncthreads();
    XcdBarrier bar = xcd_barrier_post((unsigned*)(ctl + CW_BAR), MISC + 8);
    const int lo = args.ph_lo, hi_ = args.ph_hi;
#define IN(k) (lo <= (k) && (k) < hi_)
#define REPS(k) for (int rep_ = 0; rep_ < (((k) == MK_REP_PHASE) ? MK_REP_N + 1 : 1); ++rep_)
#define SEAM(k) do { if (IN(k) && IN((k) + 1)) xcd_barrier(bar); } while (0)

    const float* x = args.in[0]; const float* mem = args.in[1]; float* out = args.out;
    float* GATES = (float*)(ws + WS_GATES); float* GA = (float*)(ws + WS_GA); float* GM = (float*)(ws + WS_GM); float* GB = (float*)(ws + WS_GB);
    float* MSa = (float*)(ws + WS_MS); float* MLa = (float*)(ws + WS_ML); float* BLa = (float*)(ws + WS_BL); float* ALa = (float*)(ws + WS_AL); float* NRM = (float*)(ws + WS_NRM); float* SSP = (float*)(ws + WS_SSP); float* DN = (float*)(ws + WS_DN); float* LSE = (float*)(ws + WS_LSE);
    bf16* MEMB = (bf16*)(ws + WS_MEMB); bf16* KV = (bf16*)(ws + WS_KV);
    bf16* Win_t = (bf16*)(ws + WS_W + W_IN); bf16* Wout_t = (bf16*)(ws + WS_W + W_OUT); bf16* Wxq_t = (bf16*)(ws + WS_W + W_XQ); bf16* Wxkv_t = (bf16*)(ws + WS_W + W_XKV);
    bf16* Wxo_t = (bf16*)(ws + WS_W + W_XO); bf16* Wup_t = (bf16*)(ws + WS_W + W_UP); bf16* Wdown_t = (bf16*)(ws + WS_W + W_DOWN);
    bf16* ACT0 = (bf16*)(ws + WS_ACT0); bf16* ACT1 = (bf16*)(ws + WS_ACT1); bf16* CQK = ACT1; bf16* PROJ = (bf16*)(ws + WS_PROJ); bf16* HID = PROJ;
    bf16* OG = (bf16*)((unsigned char*)out + OUT_OG); bf16* DC = (bf16*)((unsigned char*)out + OUT_DC); bf16* XRES = (bf16*)(ws + WS_XRES);

    for (int layer = 0; layer < DEPTH; ++layer) {
        const int pb = layer * NPH;
        const float* norm_mix_g = args.in[2] + (size_t)layer * DM;
        const float* w_in = args.in[3] + (size_t)layer * DM * INW;
        const float* conv_w = args.in[4] + (size_t)layer * 3 * 1536;
        const float* gate_b = args.in[5] + (size_t)layer * 24;
        const float* diff_lambda = args.in[6] + (size_t)layer * 256;
        const float* head_norm_g = args.in[7] + (size_t)layer * DM;
        const float* w_out = args.in[8] + (size_t)layer * DM * DM;
        const float* norm_x_g = args.in[9] + (size_t)layer * DM;
        const float* norm_mem_g = args.in[10] + (size_t)layer * DM;
        const float* w_xq = args.in[11] + (size_t)layer * DM * DM;
        const float* w_xkv = args.in[12] + (size_t)layer * DM * 2 * DM;
        const float* w_xo = args.in[13] + (size_t)layer * DM * DM;
        const float* norm_mlp_g = args.in[14] + (size_t)layer * DM;
        const float* w_up = args.in[15] + (size_t)layer * DM * DFF;
        const float* w_down = args.in[16] + (size_t)layer * DFF * DM;

        REPS(0) if (IN(pb + 0)) { PH_IDS
            LAS float* scr = (LAS float*)(lds + RING_OFF + wave * 16384);
            constexpr int I_IN = (DM / 64) * (INWP / 32), I_SQ = (DM / 64) * (DM / 32), I_KV = (DM / 64) * (2 * DM / 32), I_UP = (DM / 64) * (DFF / 32), I_DN = (DFF / 64) * (DM / 32);
            constexpr int NITEMS = I_IN + 3 * I_SQ + I_KV + I_UP + I_DN;
#define TR_DECODE(P, it_) int P##r = (it_); const float* P##W; bf16* P##T; const float* P##g; int P##K, P##N, P##nb, P##lo = 0, P##hi = 0; \
                if (P##r < I_IN) { P##W = w_in; P##T = Win_t; P##g = norm_mix_g; P##K = DM; P##N = INW; P##nb = INWP / 32; P##lo = PB_Q; P##hi = PB_K; } \
                else if ((P##r -= I_IN) < I_SQ) { P##W = w_out; P##T = Wout_t; P##g = nullptr; P##K = DM; P##N = DM; P##nb = DM / 32; } \
                else if ((P##r -= I_SQ) < I_SQ) { P##W = w_xq; P##T = Wxq_t; P##g = norm_x_g; P##K = DM; P##N = DM; P##nb = DM / 32; } \
                else if ((P##r -= I_SQ) < I_KV) { P##W = w_xkv; P##T = Wxkv_t; P##g = norm_mem_g; P##K = DM; P##N = 2 * DM; P##nb = 2 * DM / 32; } \
                else if ((P##r -= I_KV) < I_SQ) { P##W = w_xo; P##T = Wxo_t; P##g = nullptr; P##K = DM; P##N = DM; P##nb = DM / 32; } \
                else if ((P##r -= I_SQ) < I_UP) { P##W = w_up; P##T = Wup_t; P##g = norm_mlp_g; P##K = DM; P##N = DFF; P##nb = DFF / 32; } \
                else { P##r -= I_UP; P##W = w_down; P##T = Wdown_t; P##g = nullptr; P##K = DFF; P##N = DM; P##nb = DM / 32; }
            for (int it = gw; it < NITEMS; it += 2 * NGW) {
                float va[32], vb[32]; const bool two = it + NGW < NITEMS;
                TR_DECODE(a_, it) TR_DECODE(b_, two ? it + NGW : it)
                tr_load(va, a_W, a_N, a_nb, a_r, lane);
                tr_load(vb, b_W, b_N, b_nb, b_r, lane);
                tr_store(va, a_T, a_g, a_K, a_nb, a_r, scr, lane, a_lo, a_hi, 0.125f * LOG2E);
                if (two) tr_store(vb, b_T, b_g, b_K, b_nb, b_r, scr, lane, b_lo, b_hi, 0.125f * LOG2E);
            }
#undef TR_DECODE
            rownorm_bf16(mem, MEMB, NBATCH * MEML, gw, NGW, lane);
            if (layer == 0) rownorm_bf16(x, ACT0, M, gw, NGW, lane);
            __syncthreads();
        }
        SEAM(pb + 0);
        REPS(1) if (IN(pb + 1)) {
            pg8::Gemm g{MEMB, Wxkv_t, NBATCH * MEML, 2 * DM, DM}; pg8::StaticOrder S; S.init(NBATCH * MEML, 2 * DM, G, bx);
            pg8::EpiBf16<0, false> E{KV, 2 * DM, 1.f, nullptr, 0, nullptr};
            pg8::gemm_phase<pg8::EpiBf16<0, false>, pg8::StaticOrder, PG8_ALIGN, PG8_SP2>(lds + RING_OFF, g, S, E);
        }
        SEAM(pb + 1);
        REPS(2) if (IN(pb + 2)) {
            pg8::Gemm g{layer == 0 ? ACT0 : XRES, Win_t, M, INWP, DM}; pg8::StaticOrder S; S.init(M, INWP, G, bx);
            pg8::EpiBf16<0, true> E{PROJ, INWP, 1.f, GATES, PC_G, layer == 0 ? nullptr : SSP};
            pg8::gemm_phase<pg8::EpiBf16<0, true>, pg8::StaticOrder, PG8_ALIGN, PG8_SP2>(lds + RING_OFF, g, S, E);
        }
        SEAM(pb + 2);
        REPS(3) if (IN(pb + 3)) { PH_IDS
#if (MK_SKIP & 7)
            for (size_t i = gt; i < (size_t)M * DM / 8; i += NTH) ((v4u*)ACT0)[i] = (v4u){0u, 0u, 0u, 0u};
#endif
            for (size_t it = gt; it < (size_t)M * 192; it += NTH) {
                const size_t m = it / 192; const int c8 = (int)(it % 192) * 8; const int t = (int)(m % T);
                const bf16* up = PROJ + m * INWP + PC_QK + c8;
                const bf16x8 u1 = *(const bf16x8*)up; bf16x8 u0 = {0, 0, 0, 0, 0, 0, 0, 0}, u2 = {0, 0, 0, 0, 0, 0, 0, 0};
                if (t > 0) u0 = *(const bf16x8*)(up - INWP);
                if (t < T - 1) u2 = *(const bf16x8*)(up + INWP);
                float y[8];
#pragma unroll
                for (int e = 0; e < 8; ++e) { const float xx = conv_w[c8 + e] * bf2f((unsigned short)u0[e]) + conv_w[1536 + c8 + e] * bf2f((unsigned short)u1[e]) + conv_w[3072 + c8 + e] * bf2f((unsigned short)u2[e]);
                    float s = xx / (1.f + __expf(-xx)); if (c8 < 768) s *= 0.08838834764831845f; y[e] = s; }
                *(bf16x8*)(CQK + m * 1536 + c8) = pack8(y);
            }
            {   LAS unsigned* NM = (LAS unsigned*)(lds + RING_OFF);
                if (tid < 64) NM[tid] = 0u;
                __syncthreads();
                for (size_t it = gt; it < (size_t)M * 128; it += NTH) { const size_t m = it >> 7; const int rem = (int)(it & 127);
                    const bf16x8 u = *(const bf16x8*)(PROJ + m * INWP + PB_Q + rem * 8); float s = 0.f;
#pragma unroll
                    for (int e = 0; e < 8; ++e) { const float v = bf2f((unsigned short)u[e]); s = fmaf(v, v, s); }
                    s += __shfl_xor(s, 1); s += __shfl_xor(s, 2); s += __shfl_xor(s, 4);
                    if ((lane & 7) == 0) atomicMax((unsigned*)(NM + (int)(m / T) * 16 + (rem >> 3)), __float_as_uint(s)); }
                __syncthreads();
                if (tid < 64) NRM[(size_t)bx * 64 + tid] = __uint_as_float(NM[tid]);
            }
            for (int task = gw; task < 48 * NCH; task += NGW) {
                const int seq = task / NCH, c = task % NCH, dir = seq / 24, bh = seq % 24, b = bh / CH, h = bh % CH;
                const float bi = gate_b[(dir ? 2 : 0) * CH + h], bf_ = gate_b[(dir ? 3 : 1) * CH + h];
                const int i0 = 2 * lane, i1 = 2 * lane + 1;
                const int t0 = c * LC + (dir ? LC - 1 - i0 : i0), t1 = c * LC + (dir ? LC - 1 - i1 : i1);
                const float* g0 = GATES + ((size_t)b * T + t0) * 24; const float* g1 = GATES + ((size_t)b * T + t1) * 24;
                const float li0 = g0[(dir ? 2 : 0) * CH + h] + bi, li1 = g1[(dir ? 2 : 0) * CH + h] + bi;
                const float lf0 = log_sigmoid(g0[(dir ? 3 : 1) * CH + h] + bf_), lf1 = log_sigmoid(g1[(dir ? 3 : 1) * CH + h] + bf_);
                const float incl = wave_incl_sum(lf0 + lf1, lane);
                const float bc1 = incl, bc0 = incl - lf1;
                const float a0 = li0 - bc0, a1 = li1 - bc1;
                const float imx = wave_incl_max(fmaxf(a0, a1), lane);
                float emx = __shfl_up(imx, 1); if (lane == 0) emx = -INFINITY;
                const size_t sq = (size_t)seq * T;
                GA[sq + t0] = a0; GA[sq + t1] = a1; GM[sq + t0] = fmaxf(emx, a0); GM[sq + t1] = imx; GB[sq + t0] = bc0; GB[sq + t1] = bc1;
                if (lane == 63) { BLa[seq * NCH + c] = bc1; ALa[seq * NCH + c] = imx; }
            }
        }
        SEAM(pb + 3);
        REPS(4) if (IN(pb + 4)) {
            LAS float* TMS = (LAS float*)(lds + TBL_OFF); LAS float* TML = TMS + 48 * NCH;
            {   PH_IDS
                if (tid < 48) { const int seq = tid, dir = seq / 24; float ms = 0.f;
                    for (int p = 0; p < NCH; ++p) { const int c = dir ? NCH - 1 - p : p; const float ml = fmaxf(ms, ALa[seq * NCH + c]);
                        TMS[seq * NCH + c] = ms; TML[seq * NCH + c] = ml; if (bx == 0) { MSa[seq * NCH + c] = ms; MLa[seq * NCH + c] = ml; }
                        ms = BLa[seq * NCH + c] + ml; } }
                __syncthreads(); }
#if !(MK_SKIP & 1)
            REPS(40) for (int u = bx; u < 1152; u += G) { const int xc = u & 7, w = u >> 3, bh = xc + 8 * (w / 48), rem = w % 48, cfg = rem / 16, i16 = rem % 16;
                const int rho = cfg == 0 ? 0 : (cfg == 1 ? (i16 >> 2) : i16), seg = cfg == 0 ? i16 : (cfg == 1 ? (i16 & 3) : 0);
                dilattn_unit((LAS char*)lds, PROJ, OG, LSE, bh / AH, bh % AH, cfg, rho, seg); }
#endif
#if !(MK_SKIP & 4)
            REPS(41) for (int u = bx; u < 768; u += G) { const int xc = u & 7, w = u >> 3, bh = xc + 8 * (w / 32), c = w % 32;
                mlstm_dc_unit((LAS char*)lds, CQK, PROJ, GA, TML, DC, DN, bh / CH, bh % CH, c); }
#endif
        }
        SEAM(pb + 4);
        REPS(5) if (IN(pb + 5)) { PH_IDS
#if !(MK_SKIP & 4)
            for (size_t g2 = gt; g2 < (size_t)48 * 2048; g2 += NTH) { const int sq = (int)(g2 / 2048), e8 = (int)(g2 % 2048) * 8, dir = sq / 24;
                float S[8];
#pragma unroll
                for (int e = 0; e < 8; ++e) S[e] = 0.f;
                for (int p0 = 0; p0 < NCH; p0 += 8) {
                    bf16x8 xv[8]; float dec[8];
#pragma unroll
                    for (int q = 0; q < 8; ++q) { const int c = dir ? NCH - 1 - (p0 + q) : p0 + q;
                        xv[q] = *(const bf16x8*)(DC + ((size_t)sq * NCH + c) * (LC * HD) + e8); dec[q] = MSa[sq * NCH + c] - MLa[sq * NCH + c]; }
                    asm volatile("" ::: "memory");
#pragma unroll
                    for (int q = 0; q < 8; ++q) { const int c = dir ? NCH - 1 - (p0 + q) : p0 + q; const float dc = expf(dec[q]);
                        *(bf16x8*)(DC + ((size_t)sq * NCH + c) * (LC * HD) + e8) = pack8(S);
#pragma unroll
                        for (int e = 0; e < 8; ++e) S[e] = fmaf(dc, S[e], bf2f((unsigned short)xv[q][e])); }
                }
            }
            for (size_t g2 = gt; g2 < (size_t)48 * 128; g2 += NTH) { const int sq = (int)(g2 / 128), d = (int)(g2 % 128), dir = sq / 24; float S = 0.f;
                for (int p0 = 0; p0 < NCH; p0 += 8) { float xv[8], dec[8];
#pragma unroll
                    for (int q = 0; q < 8; ++q) { const int c = dir ? NCH - 1 - (p0 + q) : p0 + q; xv[q] = DN[((size_t)sq * NCH + c) * HD + d]; dec[q] = MSa[sq * NCH + c] - MLa[sq * NCH + c]; }
                    asm volatile("" ::: "memory");
#pragma unroll
                    for (int q = 0; q < 8; ++q) { const int c = dir ? NCH - 1 - (p0 + q) : p0 + q; DN[((size_t)sq * NCH + c) * HD + d] = S; S = fmaf(expf(dec[q]), S, xv[q]); }
                }
            }
#endif
#if !(MK_SKIP & 1)
            for (size_t it0 = gt; it0 < (size_t)M * AH * 16; it0 += 2 * NTH) {
                float lv[2][3]; bf16x8 ov[2][3]; size_t mm[2]; int hh[2], cc[2]; bool ok[2];
#pragma unroll
                for (int k = 0; k < 2; ++k) { const size_t it = it0 + k * NTH; ok[k] = it < (size_t)M * AH * 16; const size_t itc = ok[k] ? it : it0;
                    const size_t m = itc / (AH * 16); const int rem = (int)(itc % (AH * 16)), h = rem >> 4, c8 = (rem & 15) * 8; mm[k] = m; hh[k] = h; cc[k] = c8;
#pragma unroll
                    for (int g = 0; g < 3; ++g) { lv[k][g] = LSE[(g * (size_t)M + m) * AH + h]; ov[k][g] = *(const bf16x8*)(OG + (g * (size_t)M + m) * 768 + h * 128 + c8); } }
                asm volatile("" ::: "memory");
#pragma unroll
                for (int k = 0; k < 2; ++k) { const int h = hh[k], c8 = cc[k];
                    const float mx = fmaxf(lv[k][0], fmaxf(lv[k][1], lv[k][2])); float w0 = expf(lv[k][0] - mx), w1 = expf(lv[k][1] - mx), w2 = expf(lv[k][2] - mx); const float inv = 1.f / (w0 + w1 + w2); w0 *= inv; w1 *= inv; w2 *= inv;
                    float y[8]; float ss = 0.f;
#pragma unroll
                    for (int e = 0; e < 8; ++e) { y[e] = w0 * bf2f((unsigned short)ov[k][0][e]) + w1 * bf2f((unsigned short)ov[k][1][e]) + w2 * bf2f((unsigned short)ov[k][2][e]); ss = fmaf(y[e], y[e], ss); }
                    ss += __shfl_xor(ss, 1); ss += __shfl_xor(ss, 2); ss += __shfl_xor(ss, 4); ss += __shfl_xor(ss, 8);
                    const float rs = 1.0f / sqrtf(ss * (1.f / 128.f) + EPS);
#pragma unroll
                    for (int e = 0; e < 8; ++e) y[e] *= rs * head_norm_g[h * 128 + c8 + e];
                    if (ok[k]) *(bf16x8*)(ACT0 + mm[k] * DM + h * 128 + c8) = pack8(y); }
            }
#endif
        }
        SEAM(pb + 5);
        REPS(6) if (IN(pb + 6)) { PH_IDS
#if !(MK_SKIP & 2)
            {   const float* dl = diff_lambda;
                const float s1 = wave_sum(dl[lane] * dl[64 + lane]), s2 = wave_sum(dl[128 + lane] * dl[192 + lane]);
                const float lam_init = 0.8f - 0.6f * expf(-0.3f * (float)layer);
                const float lam = expf(s1) - expf(s2) + lam_init;
                REPS(60) for (int u = bx; u < 512; u += G) { const int xc = bx & 7, rnd = u / G, idx = (xc & 3) * 32 + ((bx >> 3) & 31);
                    const int h = xc < 4 ? (rnd == 0 ? 3 : 0) : (rnd == 0 ? 2 : 1);
                    diffattn_unit((LAS char*)lds, PROJ, ACT0, head_norm_g, lam, 1.f - lam_init, NRM, G, idx / 32, h, idx % 32); }
            }
#endif
#if !(MK_SKIP & 4)
            REPS(61) for (int u = bx; u < 768; u += G) { const int xc = u & 7, w = u >> 3, bh = xc + 8 * (w / 32), c = w % 32;
                mlstm_out_unit((LAS char*)lds, CQK, PROJ, GA, GM, GB, MSa, DC, DN, ACT0, head_norm_g, bh / CH, bh % CH, c); }
#endif
        }
        SEAM(pb + 6);
        REPS(7) if (IN(pb + 7)) {
            pg8::Gemm g{ACT0, Wout_t, M, DM, DM}; pg8::StaticOrder S; S.init(M, DM, G, bx);
            if (layer == 0) { pg8::EpiResBf16<true> E{x, (MK_REP_PHASE == 7 && rep_ < MK_REP_N) ? ACT1 : XRES, SSP}; pg8::gemm_phase<pg8::EpiResBf16<true>, pg8::StaticOrder, PG8_ALIGN, PG8_SP2>(lds + RING_OFF, g, S, E); }
            else { pg8::EpiResBf16<false> E{XRES, (MK_REP_PHASE == 7 && rep_ < MK_REP_N) ? ACT1 : XRES, SSP}; pg8::gemm_phase<pg8::EpiResBf16<false>, pg8::StaticOrder, PG8_ALIGN, PG8_SP2>(lds + RING_OFF, g, S, E); }
        }
        SEAM(pb + 7);
        REPS(9) if (IN(pb + 9)) {
            pg8::Gemm g{XRES, Wxq_t, M, DM, DM}; pg8::StaticOrder S; S.init(M, DM, G, bx);
            pg8::EpiBf16<0, false> E{ACT0, DM, 0.044194173824159216f * LOG2E, nullptr, 0, SSP};
            pg8::gemm_phase<pg8::EpiBf16<0, false>, pg8::StaticOrder, PG8_ALIGN, PG8_SP2>(lds + RING_OFF, g, S, E);
        }
        SEAM(pb + 9);
        REPS(10) if (IN(pb + 10)) {
            for (int u = bx; u < 256; u += G) { const int xc = u & 7, w = u >> 3, bh = xc + 8 * (w / 16), qb = w % 16;
                xattn_unit((LAS char*)lds, ACT0, KV, ACT1, bh / XH, bh % XH, qb); }
        }
        SEAM(pb + 10);
        REPS(11) if (IN(pb + 11)) {
            pg8::Gemm g{ACT1, Wxo_t, M, DM, DM}; pg8::StaticOrder S; S.init(M, DM, G, bx);
            pg8::EpiResBf16<false> E{XRES, (MK_REP_PHASE == 11 && rep_ < MK_REP_N) ? ACT0 : XRES, SSP};
            pg8::gemm_phase<pg8::EpiResBf16<false>, pg8::StaticOrder, PG8_ALIGN, PG8_SP2>(lds + RING_OFF, g, S, E);
        }
        SEAM(pb + 11);
        REPS(13) if (IN(pb + 13)) {
            pg8::Gemm g{XRES, Wup_t, M, DFF, DM}; pg8::StaticOrder S; S.init(M, DFF, G, bx);
            pg8::EpiBf16<1, false> E{HID, DFF, 1.f, nullptr, 0, SSP};
            pg8::gemm_phase<pg8::EpiBf16<1, false>, pg8::StaticOrder, PG8_ALIGN, PG8_SP2>(lds + RING_OFF, g, S, E);
        }
        SEAM(pb + 13);
        REPS(14) if (IN(pb + 14)) {
            pg8::Gemm g{HID, Wdown_t, M, DM, DFF}; pg8::StaticOrder S; S.init(M, DM, G, bx);
            pg8::EpiResBf16<false> E{XRES, (MK_REP_PHASE == 14 && rep_ < MK_REP_N) ? ACT1 : XRES, SSP};
            pg8::gemm_phase<pg8::EpiResBf16<false>, pg8::StaticOrder, PG8_ALIGN, PG8_SP2>(lds + RING_OFF, g, S, E);
        }
        SEAM(pb + 14);
    }
    if (IN(DEPTH * NPH)) { PH_IDS
        const float* fg = args.in[17];
        for (int m = gw; m < M; m += NGW) {
            const unsigned long long* hr = (const unsigned long long*)(XRES + (size_t)m * DM) + lane; f32x4* xr = (f32x4*)(out + (size_t)m * DM) + lane; const f32x4* gr = (const f32x4*)fg + lane;
            const float rs = 1.0f / sqrtf(wave_sum(lane < 32 ? SSP[(size_t)m * 32 + lane] : 0.f) * (1.f / DM) + EPS);
#pragma unroll
            for (int j = 0; j < 8; ++j) { const unsigned long long w = hr[64 * j]; const unsigned lo = (unsigned)w, hi2 = (unsigned)(w >> 32);
                const f32x4 v = {__uint_as_float(lo << 16), __uint_as_float(lo & 0xffff0000u), __uint_as_float(hi2 << 16), __uint_as_float(hi2 & 0xffff0000u)};
                xr[64 * j] = v * rs * gr[64 * j]; }
        }
    }
#undef IN
#undef SEAM
}

extern "C" void kernel_launch(void* const* d_in, const int* in_sizes, int n_in, void* d_out, int out_size, void* d_ws, size_t ws_size, hipStream_t stream) {
    static int grid = 0;
    if (grid == 0) {
        if (n_in != 18 || in_sizes[0] != M * DM || out_size != M * DM || ws_size < WS_END) {
            fprintf(stderr, "kernel_launch: shape / workspace mismatch (n_in %d, in0 %d, out %d, ws %zu, need %zu); nothing launched\n", n_in, n_in > 0 ? in_sizes[0] : -1, out_size, ws_size, (size_t)WS_END); grid = -1; return; }
        int dev = 0, cus = 0, per_cu = 0;
        if (hipGetDevice(&dev) != hipSuccess || hipDeviceGetAttribute(&cus, hipDeviceAttributeMultiprocessorCount, dev) != hipSuccess) { grid = -1; return; }
        if (hipFuncSetAttribute((const void*)enc_fwd, hipFuncAttributeMaxDynamicSharedMemorySize, LDS_BYTES) != hipSuccess) { fprintf(stderr, "kernel_launch: hipFuncSetAttribute failed\n"); grid = -1; return; }
        if (hipOccupancyMaxActiveBlocksPerMultiprocessor(&per_cu, (const void*)enc_fwd, NWAVES * 64, LDS_BYTES) != hipSuccess || per_cu < 1) { fprintf(stderr, "kernel_launch: occupancy query says %d blocks per CU\n", per_cu); }
        (void)hipGetLastError();
        grid = cus;
    }
    if (grid < 0) return;
    if (hipMemsetAsync((char*)d_ws + WS_CTL, 0, CTL_ZERO_BYTES, stream) != hipSuccess) return;
    Args a{};
    for (int i = 0; i < 18; ++i) a.in[i] = (const float*)d_in[i];
    a.out = (float*)d_out; a.ws = (unsigned char*)d_ws;
#if MK_PER_PHASE
    for (int p = 0; p < NPHT; ++p) { a.ph_lo = p; a.ph_hi = p + 1; hipLaunchKernelGGL(enc_fwd, dim3(grid), dim3(NWAVES * 64), LDS_BYTES, stream, a); }
#else
    a.ph_lo = 0; a.ph_hi = NPHT;
    hipLaunchKernelGGL(enc_fwd, dim3(grid), dim3(NWAVES * 64), LDS_BYTES, stream, a);
#endif
    const hipError_t le = hipPeekAtLastError();
    if (le != hipSuccess) fprintf(stderr, "kernel_launch: launch failed: %s\n", hipGetErrorName(le));
}
```

```cpp
#include <hip/hip_runtime.h>
#include <cstdio>
#include <cstdint>
#include <cmath>

#ifndef MK_PER_PHASE
#define MK_PER_PHASE 0
#endif
#ifndef MK_SKIP
#define MK_SKIP 0
#endif

#ifndef MK_REP_PHASE
#define MK_REP_PHASE -1
#endif
#ifndef MK_REP_N
#define MK_REP_N 1
#endif

#ifndef MK_TIME_A
#define MK_TIME_A -1
#endif
#ifndef MK_TIME_BLK
#define MK_TIME_BLK 0
#endif
#ifndef MK_TIME_DIV
#define MK_TIME_DIV 50000.f
#endif
#ifndef MK_TIME_B
#define MK_TIME_B -1
#endif

#ifndef MK_SKEW_TICKS
#define MK_SKEW_TICKS 0
#endif

#ifndef MK_P9_MODE
#define MK_P9_MODE 0
#endif

#ifndef MK_A_MODE
#define MK_A_MODE 0
#endif

namespace pg8 {
#define PG8_LAS __attribute__((address_space(3)))
typedef unsigned short bf16_t;
typedef short bf16x8 __attribute__((ext_vector_type(8)));
typedef float f32x4 __attribute__((ext_vector_type(4)));
typedef unsigned u32x4 __attribute__((ext_vector_type(4)));
constexpr int BM = 256, BK = 64, HALF = 128, HTB = HALF * BK * 2  , STAGE_BYTES = 8 * HTB, NXCD = 8, WGM = 8;

__host__ __device__ __forceinline__ int lds_byte(int r, int c) { const int st = (r >> 4) * 2 + (c >> 5), rr = r & 15, cc = c & 31, ob = rr * 64 + cc * 2; return st * 1024 + (ob ^ (((ob >> 9) & 1) << 5)); }
__host__ __device__ __forceinline__ void stage_rc(int b, int& R, int& C) { const int st = b / 1024, sb = b % 1024, swz = sb ^ (((sb >> 9) & 1) << 5); R = (st >> 1) * 16 + swz / 64; C = (st & 1) * 32 + (swz % 64) / 2; }
__host__ __device__ __forceinline__ int perm32(int rho) { const int n = rho >> 4, i = rho & 15; return 8 * (i >> 2) + 4 * n + (i & 3); }

struct Unit { int pm, pn; };
struct Gemm { const bf16_t* A; const bf16_t* Bt; int M, N, K; };

struct StaticOrder {
    int nM, nN, nwg, G, c;
    __host__ __device__ void init(int M, int N, int G_, int c_) { nM = M / BM; nN = N / BM; nwg = nM * nN; G = G_; c = c_; }
    __host__ __device__ bool next(int i, Unit& u) const {
        const long L = (long)i * G + c; if (L >= nwg) return false;
        int wgid = (int)L; { const int q = nwg / NXCD, r = nwg % NXCD, xcd = wgid % NXCD, off = wgid / NXCD; wgid = (xcd < r ? xcd * (q + 1) : r * (q + 1) + (xcd - r) * q) + off; }
        const int nig = WGM * nN, gid = wgid / nig, fm = gid * WGM, gsz = (nM - fm) < WGM ? (nM - fm) : WGM;
        u.pm = fm + ((wgid % nig) % gsz); u.pn = (wgid % nig) / gsz; return true;
    }
    __device__ __forceinline__ void a_ready(const Unit&) const {}
    __device__ __forceinline__ void done(const Unit&) const {}
};

__device__ __forceinline__ unsigned cvt_pk_bf16(float lo, float hi) { unsigned r; asm volatile("v_cvt_pk_bf16_f32 %0, %1, %2" : "=v"(r) : "v"(lo), "v"(hi)); return r; }
typedef float f32x2 __attribute__((ext_vector_type(2)));

template <int ACT, bool SIDE> struct EpiBf16 {
    static constexpr bool PERM = true, AFTER_DRAIN = false;
    bf16_t* O; int ldc; float scale; float* side; int side_c0; const PG8_LAS float* rtab; int dry = 0;
    __device__ __forceinline__ void operator()(const f32x4 (&acc)[2][2][4][2], const Unit& u, int wr, int wc, int fr, int fq, int ui) const {
        const int row0 = u.pm * BM + wr * 64 + fr; const int col0 = u.pn * BM + wc * 32 + 8 * fq;
        if (dry) { float s = 0.f;
#pragma unroll
            for (int ai = 0; ai < 2; ++ai)
#pragma unroll
                for (int bj = 0; bj < 2; ++bj)
#pragma unroll
                    for (int m = 0; m < 4; ++m)
#pragma unroll
                        for (int n = 0; n < 2; ++n) s += acc[ai][bj][m][n][0] + acc[ai][bj][m][n][1] + acc[ai][bj][m][n][2] + acc[ai][bj][m][n][3];
            if (s == 1.2345e30f) O[0] = 0; return; }
        float fac[2][4];
#pragma unroll
        for (int ai = 0; ai < 2; ++ai)
#pragma unroll
            for (int m = 0; m < 4; ++m) fac[ai][m] = rtab ? scale * rtab[ui * 256 + wr * 64 + fr + ai * HALF + m * 16] : scale;
#pragma unroll
        for (int ai = 0; ai < 2; ++ai)
#pragma unroll
            for (int m = 0; m < 4; ++m) { const int row = row0 + ai * HALF + m * 16; bf16_t* rowp = O + (size_t)row * ldc + col0;
                const float f = fac[ai][m];
                if (SIDE) { const int sc = col0 - side_c0;
                    if (sc >= 0 && sc < 24) { float* sp = side + (size_t)row * 24 + sc; *(f32x4*)sp = acc[ai][0][m][0] * f; *(f32x4*)(sp + 4) = acc[ai][0][m][1] * f; } }
#pragma unroll
                for (int bj = 0; bj < 2; ++bj) { f32x4 v0 = acc[ai][bj][m][0] * f, v1 = acc[ai][bj][m][1] * f;
                    if (ACT == 1) {
#pragma unroll
                        for (int e = 0; e < 4; ++e) { const float a = fmaxf(v0[e], 0.f), b = fmaxf(v1[e], 0.f); v0[e] = a * a; v1[e] = b * b; } }
                    u32x4 w; w.x = cvt_pk_bf16(v0[0], v0[1]); w.y = cvt_pk_bf16(v0[2], v0[3]); w.z = cvt_pk_bf16(v1[0], v1[1]); w.w = cvt_pk_bf16(v1[2], v1[3]);
                    *(u32x4*)(rowp + bj * HALF) = w; } }
    }
};
template <bool BASE_F32> struct EpiResBf16 {
    static constexpr bool PERM = true, AFTER_DRAIN = false;
    const void* base; bf16_t* hb; float* ss;
    __device__ __forceinline__ void operator()(const f32x4 (&acc)[2][2][4][2], const Unit& u, int wr, int wc, int fr, int fq, int ui) const {
        const int row0 = u.pm * BM + wr * 64 + fr, col0 = u.pn * BM + wc * 32 + 8 * fq;
        if constexpr (!BASE_F32) {
            u32x4 bw[8][2];
#pragma unroll
            for (int k = 0; k < 6; ++k)
#pragma unroll
                for (int bj = 0; bj < 2; ++bj) bw[k][bj] = *(const u32x4*)((const bf16_t*)base + (size_t)(row0 + (k >> 2) * HALF + (k & 3) * 16) * 2048 + col0 + bj * HALF);
#pragma unroll
            for (int k = 0; k < 8; ++k) { const int ai = k >> 2, m = k & 3; const int row = row0 + ai * HALF + m * 16; const size_t off = (size_t)row * 2048 + col0; float s2 = 0.f;
                asm volatile("" ::: "memory");
                if (k + 6 < 8) {
#pragma unroll
                    for (int bj = 0; bj < 2; ++bj) bw[k + 6][bj] = *(const u32x4*)((const bf16_t*)base + (size_t)(row0 + ((k + 6) >> 2) * HALF + ((k + 6) & 3) * 16) * 2048 + col0 + bj * HALF); }
#pragma unroll
                for (int bj = 0; bj < 2; ++bj) { const size_t o = off + bj * HALF; const u32x4 w = bw[k][bj];
                    const f32x4 b0 = {__uint_as_float(w.x << 16), __uint_as_float(w.x & 0xffff0000u), __uint_as_float(w.y << 16), __uint_as_float(w.y & 0xffff0000u)};
                    const f32x4 b1 = {__uint_as_float(w.z << 16), __uint_as_float(w.z & 0xffff0000u), __uint_as_float(w.w << 16), __uint_as_float(w.w & 0xffff0000u)};
                    const f32x4 v0 = b0 + acc[ai][bj][m][0], v1 = b1 + acc[ai][bj][m][1];
                    s2 += ((v0[0] * v0[0] + v0[1] * v0[1]) + (v0[2] * v0[2] + v0[3] * v0[3])) + ((v1[0] * v1[0] + v1[1] * v1[1]) + (v1[2] * v1[2] + v1[3] * v1[3]));
                    u32x4 w2; w2.x = cvt_pk_bf16(v0[0], v0[1]); w2.y = cvt_pk_bf16(v0[2], v0[3]); w2.z = cvt_pk_bf16(v1[0], v1[1]); w2.w = cvt_pk_bf16(v1[2], v1[3]);
                    *(u32x4*)(hb + o) = w2; }
                s2 += __shfl_xor(s2, 16); s2 += __shfl_xor(s2, 32);
                if (fq == 0) ss[(size_t)row * 32 + u.pn * 4 + wc] = s2; }
        } else {
#pragma unroll
            for (int ai = 0; ai < 2; ++ai) {
                f32x4 b0[4][2], b1[4][2];
#pragma unroll
                for (int m = 0; m < 4; ++m)
#pragma unroll
                    for (int bj = 0; bj < 2; ++bj) { const size_t o = (size_t)(row0 + ai * HALF + m * 16) * 2048 + col0 + bj * HALF;
                        b0[m][bj] = *(const f32x4*)((const float*)base + o); b1[m][bj] = *(const f32x4*)((const float*)base + o + 4); }
                asm volatile("" ::: "memory");
#pragma unroll
                for (int m = 0; m < 4; ++m) { const int row = row0 + ai * HALF + m * 16; const size_t off = (size_t)row * 2048 + col0; float s2 = 0.f;
#pragma unroll
                    for (int bj = 0; bj < 2; ++bj) { const size_t o = off + bj * HALF;
                        const f32x4 v0 = b0[m][bj] + acc[ai][bj][m][0], v1 = b1[m][bj] + acc[ai][bj][m][1];
                        s2 += ((v0[0] * v0[0] + v0[1] * v0[1]) + (v0[2] * v0[2] + v0[3] * v0[3])) + ((v1[0] * v1[0] + v1[1] * v1[1]) + (v1[2] * v1[2] + v1[3] * v1[3]));
                        u32x4 w2; w2.x = cvt_pk_bf16(v0[0], v0[1]); w2.y = cvt_pk_bf16(v0[2], v0[3]); w2.z = cvt_pk_bf16(v1[0], v1[1]); w2.w = cvt_pk_bf16(v1[2], v1[3]);
                        *(u32x4*)(hb + o) = w2; }
                    s2 += __shfl_xor(s2, 16); s2 += __shfl_xor(s2, 32);
                    if (fq == 0) ss[(size_t)row * 32 + u.pn * 4 + wc] = s2; } }
        }
    }
};

template <class Epi, class Sched, bool ALIGN_EPI = false, bool SP2 = false>
__device__ __forceinline__ void gemm_phase(PG8_LAS unsigned char* lds, const Gemm g, const Sched& S, const Epi& E) {
    int tid_ = threadIdx.x; asm volatile("" : "+v"(tid_)); const int tid = tid_, wid = __builtin_amdgcn_readfirstlane(tid >> 6), lane = tid & 63, wr = wid >> 2, wc = wid & 3, fr = lane & 15, fq = lane >> 4;
    const int K = g.K, nt = K / BK;
    unsigned voffA[2], voffB[2];
#pragma unroll
    for (int i = 0; i < 2; ++i) { int R, C; stage_rc(tid * 16 + i * 8192, R, C); const int Rb = Epi::PERM ? ((R & ~31) + perm32(R & 31)) : R;
        voffA[i] = (unsigned)(R * K + C) * 2u; voffB[i] = (unsigned)(Rb * K + C) * 2u; }
    const size_t kstep = (size_t)(BK * 2);
    const size_t hstep = (size_t)HALF * K * 2;
    const size_t tstep = 2 * hstep;
    const unsigned ldsw = (unsigned)wid * 1024u;
    const int aoff = lds_byte(wr * 64 + fr, fq * 8), boff = lds_byte(wc * 32 + fr, fq * 8);
#define PG8_SA(b, h) (((b) * 2 + (h)) * HTB)
#define PG8_SB(b, h) ((4 + (b) * 2 + (h)) * HTB)
#define PG8_STAGE(bufoff, gbase, voff) do { _Pragma("unroll") for (int _i = 0; _i < 2; ++_i) \
        __builtin_amdgcn_global_load_lds((const unsigned*)((const char*)(gbase) + (voff)[_i]), (PG8_LAS unsigned*)(lds + (bufoff) + ldsw + _i * 8192), 16, 0, 0); } while (0)
#define PG8_LDA(dst, b, h) do { _Pragma("unroll") for (int m = 0; m < 4; ++m) _Pragma("unroll") for (int k = 0; k < 2; ++k) dst[m][k] = *(const PG8_LAS bf16x8*)(lds + PG8_SA(b, h) + aoff + m * 2048 + k * 1024); } while (0)
#define PG8_LDB(dst, b, h) do { _Pragma("unroll") for (int n = 0; n < 2; ++n) _Pragma("unroll") for (int k = 0; k < 2; ++k) dst[n][k] = *(const PG8_LAS bf16x8*)(lds + PG8_SB(b, h) + boff + n * 2048 + k * 1024); } while (0)
#define PG8_MMA(ai, bj, At, Bt) do { __builtin_amdgcn_s_setprio(1); _Pragma("unroll") for (int m = 0; m < 4; ++m) _Pragma("unroll") for (int n = 0; n < 2; ++n) _Pragma("unroll") for (int k = 0; k < 2; ++k) \
        acc[ai][bj][m][n] = __builtin_amdgcn_mfma_f32_16x16x32_bf16(Bt[n][k], At[m][k], acc[ai][bj][m][n], 0, 0, 0); __builtin_amdgcn_s_setprio(0); } while (0)
#define PG8_WAIT_V(n) asm volatile("s_waitcnt vmcnt(" #n ")" ::: "memory")
#define PG8_WAIT_L(n) asm volatile("s_waitcnt lgkmcnt(" #n ")" ::: "memory")
#define PG8_BAR __builtin_amdgcn_s_barrier()
#define PG8_SCHED __builtin_amdgcn_sched_barrier(0)
    Unit cur, nxt; int ui = 0;
    if (!S.next(0, cur)) return;
    f32x4 acc[2][2][4][2];
#pragma unroll
    for (int a = 0; a < 2; ++a)
#pragma unroll
        for (int b = 0; b < 2; ++b)
#pragma unroll
            for (int m = 0; m < 4; ++m)
#pragma unroll
                for (int n = 0; n < 2; ++n) acc[a][b][m][n] = (f32x4){0.f, 0.f, 0.f, 0.f};
    bf16x8 At[4][2], B0[2][2], B1[2][2];
    const char* cA = (const char*)g.A + (size_t)cur.pm * tstep; const char* cB = (const char*)g.Bt + (size_t)cur.pn * tstep;
    S.a_ready(cur);
    if constexpr (SP2) {
        PG8_STAGE(PG8_SB(0, 0), cB, voffB); PG8_STAGE(PG8_SB(0, 1), cB + hstep, voffB); PG8_STAGE(PG8_SA(0, 0), cA, voffA); PG8_STAGE(PG8_SA(0, 1), cA + hstep, voffA);
        if (wr == 1) PG8_BAR;
        PG8_WAIT_V(2); PG8_BAR;
        PG8_STAGE(PG8_SB(1, 0), cB + kstep, voffB); PG8_STAGE(PG8_SA(1, 0), cA + kstep, voffA); PG8_STAGE(PG8_SB(1, 1), cB + hstep + kstep, voffB);
        PG8_WAIT_V(6); PG8_BAR;
    } else {
        PG8_STAGE(PG8_SB(0, 0), cB, voffB); PG8_STAGE(PG8_SA(0, 0), cA, voffA); PG8_STAGE(PG8_SB(0, 1), cB + hstep, voffB); PG8_STAGE(PG8_SA(0, 1), cA + hstep, voffA);
        if (wr == 1) PG8_BAR;
        PG8_WAIT_V(4); PG8_BAR;
        PG8_STAGE(PG8_SB(1, 0), cB + kstep, voffB); PG8_STAGE(PG8_SA(1, 0), cA + kstep, voffA); PG8_STAGE(PG8_SB(1, 1), cB + hstep + kstep, voffB);
        PG8_WAIT_V(6); PG8_BAR;
    }
    for (;;) {
        const bool has_next = S.next(ui + 1, nxt);
        const char* nA = has_next ? (const char*)g.A + (size_t)nxt.pm * tstep : cA; const char* nB = has_next ? (const char*)g.Bt + (size_t)nxt.pn * tstep : cB;
        for (int t = 0; t < nt; t += 2) {
            const bool last = (t == nt - 2);
            const char* a1 = cA + (size_t)(t + 1) * kstep;
            const char* a2 = last ? nA : cA + (size_t)(t + 2) * kstep; const char* b2 = last ? nB : cB + (size_t)(t + 2) * kstep;
            const char* a3 = a2 + kstep; const char* b3 = b2 + kstep;
            if (last && has_next) S.a_ready(nxt);
            if constexpr (SP2) {
            PG8_LDB(B0, 0, 0); PG8_LDB(B1, 0, 1); PG8_SCHED; PG8_LDA(At, 0, 0); PG8_STAGE(PG8_SA(1, 1), a1 + hstep, voffA);
            PG8_WAIT_V(8); PG8_WAIT_L(0); PG8_BAR; PG8_MMA(0, 0, At, B0); PG8_MMA(0, 1, At, B1); PG8_BAR; PG8_SCHED;
            PG8_LDA(At, 0, 1); PG8_STAGE(PG8_SB(0, 0), b2, voffB); PG8_STAGE(PG8_SB(0, 1), b2 + hstep, voffB); PG8_STAGE(PG8_SA(0, 0), a2, voffA);
            PG8_WAIT_V(8); PG8_WAIT_L(0); PG8_BAR; PG8_MMA(1, 0, At, B0); PG8_MMA(1, 1, At, B1); PG8_BAR; PG8_SCHED;
            PG8_LDB(B0, 1, 0); PG8_LDB(B1, 1, 1); PG8_SCHED; PG8_LDA(At, 1, 0); PG8_STAGE(PG8_SA(0, 1), a2 + hstep, voffA);
            PG8_WAIT_V(8); PG8_WAIT_L(0); PG8_BAR; PG8_MMA(0, 0, At, B0); PG8_MMA(0, 1, At, B1); PG8_BAR; PG8_SCHED;
            PG8_LDA(At, 1, 1); PG8_STAGE(PG8_SB(1, 0), b3, voffB); PG8_STAGE(PG8_SB(1, 1), b3 + hstep, voffB); PG8_STAGE(PG8_SA(1, 0), a3, voffA);
            PG8_WAIT_V(8); PG8_WAIT_L(0); PG8_BAR; PG8_MMA(1, 0, At, B0); PG8_MMA(1, 1, At, B1); PG8_BAR; PG8_SCHED;
            } else {
            PG8_LDB(B0, 0, 0); PG8_SCHED; PG8_LDA(At, 0, 0); PG8_STAGE(PG8_SA(1, 1), a1 + hstep, voffA);
            PG8_WAIT_L(8); PG8_BAR; PG8_WAIT_L(0); PG8_MMA(0, 0, At, B0); PG8_BAR; PG8_SCHED;
            PG8_LDB(B1, 0, 1); PG8_STAGE(PG8_SB(0, 0), b2, voffB);
            PG8_BAR; PG8_WAIT_L(0); PG8_MMA(0, 1, At, B1); PG8_BAR;
            PG8_LDA(At, 0, 1); PG8_STAGE(PG8_SA(0, 0), a2, voffA);
            PG8_BAR; PG8_WAIT_L(0); PG8_MMA(1, 0, At, B0); PG8_BAR; PG8_SCHED;
            PG8_STAGE(PG8_SB(0, 1), b2 + hstep, voffB);
            PG8_WAIT_V(6); PG8_BAR; PG8_MMA(1, 1, At, B1); PG8_BAR;
            PG8_LDB(B0, 1, 0); PG8_SCHED; PG8_LDA(At, 1, 0); PG8_STAGE(PG8_SA(0, 1), a2 + hstep, voffA);
            PG8_WAIT_L(8); PG8_BAR; PG8_WAIT_L(0); PG8_MMA(0, 0, At, B0); PG8_BAR; PG8_SCHED;
            PG8_LDB(B1, 1, 1); PG8_STAGE(PG8_SB(1, 0), b3, voffB);
            PG8_BAR; PG8_WAIT_L(0); PG8_MMA(0, 1, At, B1); PG8_BAR;
            PG8_LDA(At, 1, 1); PG8_STAGE(PG8_SA(1, 0), a3, voffA);
            PG8_BAR; PG8_WAIT_L(0); PG8_MMA(1, 0, At, B0); PG8_BAR; PG8_SCHED;
            PG8_STAGE(PG8_SB(1, 1), b3 + hstep, voffB);
            PG8_WAIT_V(6); PG8_BAR; PG8_MMA(1, 1, At, B1); PG8_BAR;
            }
        }
        if constexpr (ALIGN_EPI) { if (wr == 0) PG8_BAR; }
        if constexpr (!Epi::AFTER_DRAIN) { E(acc, cur, wr, wc, fr, fq, ui); S.done(cur); }
        if (!has_next) break;
#pragma unroll
        for (int a = 0; a < 2; ++a)
#pragma unroll
            for (int b = 0; b < 2; ++b)
#pragma unroll
                for (int m = 0; m < 4; ++m)
#pragma unroll
                    for (int n = 0; n < 2; ++n) acc[a][b][m][n] = (f32x4){0.f, 0.f, 0.f, 0.f};
        cur = nxt; cA = nA; cB = nB; ++ui;
        if constexpr (ALIGN_EPI) { if (wr == 1) PG8_BAR; }
    }
    PG8_WAIT_V(0);
    if constexpr (!ALIGN_EPI) { if (wr == 0) PG8_BAR; }
    PG8_BAR;
    if constexpr (Epi::AFTER_DRAIN) { E.fused(acc, cur, wr, wc, fr, fq, lds, wid, lane); S.done(cur); }
#undef PG8_SA
#undef PG8_SB
#undef PG8_STAGE
#undef PG8_LDA
#undef PG8_LDB
#undef PG8_MMA
#undef PG8_WAIT_V
#undef PG8_WAIT_L
#undef PG8_BAR
#undef PG8_SCHED
}
}

constexpr int DM = 2048, NBATCH = 4, T = 4096, M = NBATCH * T, DEPTH = 2;
constexpr int HD = 128, AH = 6, BH = 4, CH = 6;
constexpr int INW = 6936, INWP = 7168;
constexpr int PA_Q = 0, PA_K = 768, PA_V = 1536, PB_Q = 2304, PB_K = 2816, PB_V = 3328, PC_QK = 3840, PC_V = 5376, PC_O = 6144, PC_G = 6912;
constexpr int MEML = 256, XH = 4, XHD = 512, DFF = 8192, NCH = 32, LC = 128;
constexpr float EPS = 1e-6f, LOG2E = 1.4426950408889634f, LN2 = 0.6931471805599453f;

#define GAS __attribute__((address_space(1)))
#define LAS __attribute__((address_space(3)))
typedef unsigned short bf16;
typedef unsigned v4u __attribute__((ext_vector_type(4)));
typedef float f32x4 __attribute__((ext_vector_type(4)));
typedef float f32x16 __attribute__((ext_vector_type(16)));
typedef short bf16x8 __attribute__((ext_vector_type(8)));
typedef short s16x4 __attribute__((ext_vector_type(4)));
typedef GAS unsigned gu32;
#define RLX_AGENT __ATOMIC_RELAXED, __HIP_MEMORY_SCOPE_AGENT
#define LDS_WAIT() asm volatile("s_waitcnt lgkmcnt(0)" ::: "memory")
#define VM_WAIT() asm volatile("s_waitcnt vmcnt(0)" ::: "memory")
#define SBAR() __builtin_amdgcn_sched_barrier(0)
__device__ __forceinline__ unsigned f2bf(float f) { unsigned u = __builtin_bit_cast(unsigned, f); return (u + 0x7fffu + ((u >> 16) & 1u)) >> 16; }
__device__ __forceinline__ unsigned pk2(float lo, float hi) { return f2bf(lo) | (f2bf(hi) << 16); }
__device__ __forceinline__ float bf2f(unsigned short b) { return __builtin_bit_cast(float, (unsigned)b << 16); }
__device__ __forceinline__ unsigned cvtpk(float lo, float hi) { unsigned r; asm volatile("v_cvt_pk_bf16_f32 %0, %1, %2" : "=v"(r) : "v"(lo), "v"(hi)); return r; }
__device__ __forceinline__ float ex2(float x) { return __builtin_amdgcn_exp2f(x); }
__device__ __forceinline__ bf16x8 pack8(const float* f) { v4u w; w.x = cvtpk(f[0], f[1]); w.y = cvtpk(f[2], f[3]); w.z = cvtpk(f[4], f[5]); w.w = cvtpk(f[6], f[7]); return __builtin_bit_cast(bf16x8, w); }
__device__ __forceinline__ bf16x8 scale8(bf16x8 q, float s) { float f[8];
#pragma unroll
    for (int j = 0; j < 8; ++j) f[j] = bf2f((unsigned short)q[j]) * s;
    return pack8(f); }

#define KSWZ(row, colB) ((row) * 256 + ((colB) ^ (((row) & 7) << 4)))
__device__ __forceinline__ int crow(int r, int hi) { return (r & 3) + 8 * (r >> 2) + 4 * hi; }
__device__ __forceinline__ int v_st(int k, int c) { const int kk = (k & ~0xC) | ((k & 4) << 1) | ((k & 8) >> 1); return ((kk >> 3) * 4 + (c >> 5)) * 512 + ((kk & 7) * 32 + (c & 31)) * 2; }
__device__ __forceinline__ int v_rd_base(int lane) { return ((lane & 3) << 3) | (((lane >> 2) & 3) << 6) | (((lane >> 4) & 1) << 5) | (((lane >> 5) & 1) << 8); }
constexpr int v_rd_off(int d0, int ks, int half) { return d0 * 512 + ks * 4096 + half * 2048; }
template <int OFF> __device__ __forceinline__ s16x4 tr_read(int vb) { s16x4 r; asm volatile("ds_read_b64_tr_b16 %0, %1 offset:%2" : "=&v"(r) : "v"(vb), "i"(OFF) : "memory"); return r; }
#define PK8(L, H) (bf16x8){L[0], L[1], L[2], L[3], H[0], H[1], H[2], H[3]}
__device__ __forceinline__ int lds_addr(const LAS void* p) { return (int)(unsigned)(size_t)p; }

template <int ND, bool ZERO>
__device__ __forceinline__ void qkt(f32x16& p0, f32x16& p1, const LAS char* Ks, const bf16x8* qr, int cboff, int r32, int hi) {
    if (ZERO) {
#pragma unroll
        for (int r = 0; r < 16; ++r) { p0[r] = 0.f; p1[r] = 0.f; } }
#pragma unroll
    for (int d0 = 0; d0 < ND; ++d0) { const int cb = cboff + (d0 * 16 + hi * 8) * 2;
        const bf16x8 b0 = *(const LAS bf16x8*)(Ks + KSWZ(r32, cb));
        const bf16x8 b1 = *(const LAS bf16x8*)(Ks + KSWZ(32 + r32, cb));
        p0 = __builtin_amdgcn_mfma_f32_32x32x16_bf16(b0, qr[d0], p0, 0, 0, 0);
        p1 = __builtin_amdgcn_mfma_f32_32x32x16_bf16(b1, qr[d0], p1, 0, 0, 0); }
}
template <int ND>
__device__ __forceinline__ void qkt_asm(f32x16& p0, f32x16& p1, const int (&ka)[ND], int tile_off, const bf16x8* qr) {
    bf16x8 b0[ND], b1[ND];
#pragma unroll
    for (int d0 = 0; d0 < ND; ++d0) { const int ad = ka[d0] + tile_off;
        asm volatile("ds_read_b128 %0, %1" : "=&v"(b0[d0]) : "v"(ad) : "memory");
        asm volatile("ds_read_b128 %0, %1 offset:8192" : "=&v"(b1[d0]) : "v"(ad) : "memory"); }
    asm volatile("s_waitcnt lgkmcnt(0)" ::: "memory"); SBAR();
#pragma unroll
    for (int d0 = 0; d0 < ND; ++d0) {
        p0 = __builtin_amdgcn_mfma_f32_32x32x16_bf16(b0[d0], qr[d0], p0, 0, 0, 0);
        p1 = __builtin_amdgcn_mfma_f32_32x32x16_bf16(b1[d0], qr[d0], p1, 0, 0, 0); }
}
template <int D0> __device__ __forceinline__ void pv_one(f32x16& od, int vb, bf16x8 pa0, bf16x8 pa1, bf16x8 pa2, bf16x8 pa3) {
    const s16x4 l0 = tr_read<v_rd_off(D0, 0, 0)>(vb), h0 = tr_read<v_rd_off(D0, 0, 1)>(vb), l1 = tr_read<v_rd_off(D0, 1, 0)>(vb), h1 = tr_read<v_rd_off(D0, 1, 1)>(vb);
    const s16x4 l2 = tr_read<v_rd_off(D0, 2, 0)>(vb), h2 = tr_read<v_rd_off(D0, 2, 1)>(vb), l3 = tr_read<v_rd_off(D0, 3, 0)>(vb), h3 = tr_read<v_rd_off(D0, 3, 1)>(vb);
    asm volatile("s_waitcnt lgkmcnt(0)" ::: "memory"); SBAR();
    od = __builtin_amdgcn_mfma_f32_32x32x16_bf16(pa0, PK8(l0, h0), od, 0, 0, 0);
    od = __builtin_amdgcn_mfma_f32_32x32x16_bf16(pa1, PK8(l1, h1), od, 0, 0, 0);
    od = __builtin_amdgcn_mfma_f32_32x32x16_bf16(pa2, PK8(l2, h2), od, 0, 0, 0);
    od = __builtin_amdgcn_mfma_f32_32x32x16_bf16(pa3, PK8(l3, h3), od, 0, 0, 0);
}
template <int BASE> __device__ __forceinline__ bf16x8 pk4(const f32x16& P) {
    const unsigned a0 = cvtpk(P[BASE + 0], P[BASE + 1]), a1 = cvtpk(P[BASE + 2], P[BASE + 3]), b0 = cvtpk(P[BASE + 4], P[BASE + 5]), b1 = cvtpk(P[BASE + 6], P[BASE + 7]);
    auto r0 = __builtin_amdgcn_permlane32_swap(a0, b0, false, false); auto r1 = __builtin_amdgcn_permlane32_swap(a1, b1, false, false);
    v4u w = {r0[0], r1[0], r0[1], r1[1]}; return __builtin_bit_cast(bf16x8, w);
}
__device__ __forceinline__ float xhalf_max(float v) { auto rr = __builtin_amdgcn_permlane32_swap(__float_as_uint(v), __float_as_uint(v), false, false); return fmaxf(__uint_as_float(rr[0]), __uint_as_float(rr[1])); }
__device__ __forceinline__ float xhalf_sum(float v) { auto rr = __builtin_amdgcn_permlane32_swap(__float_as_uint(v), __float_as_uint(v), false, false); return __uint_as_float(rr[0]) + __uint_as_float(rr[1]); }
__device__ __forceinline__ float sm_update(f32x16& p0, f32x16& p1, float& m, float& l) {
    float pmax = p0[0];
#pragma unroll
    for (int r = 1; r < 16; ++r) pmax = fmaxf(pmax, p0[r]);
#pragma unroll
    for (int r = 0; r < 16; ++r) pmax = fmaxf(pmax, p1[r]);
    pmax = xhalf_max(pmax);
    const float mn = fmaxf(m, pmax), alpha = ex2(m - mn); m = mn;
    float ps = 0.f;
#pragma unroll
    for (int r = 0; r < 16; ++r) { p0[r] = ex2(p0[r] - mn); ps += p0[r]; }
#pragma unroll
    for (int r = 0; r < 16; ++r) { p1[r] = ex2(p1[r] - mn); ps += p1[r]; }
    ps = xhalf_sum(ps);
    l = l * alpha + ps; return alpha;
}
__device__ __forceinline__ float sm_update2(f32x16& p0, f32x16& p1, f32x16& p2, f32x16& p3, float& m, float& l) {
    float pmax = p0[0];
#pragma unroll
    for (int r = 0; r < 16; ++r) { pmax = fmaxf(pmax, fmaxf(p0[r], p1[r])); pmax = fmaxf(pmax, fmaxf(p2[r], p3[r])); }
    pmax = xhalf_max(pmax);
    const float mn = fmaxf(m, pmax), alpha = ex2(m - mn); m = mn;
    float ps = 0.f, ps2 = 0.f;
#pragma unroll
    for (int r = 0; r < 16; ++r) { p0[r] = ex2(p0[r] - mn); ps += p0[r]; p2[r] = ex2(p2[r] - mn); ps2 += p2[r]; }
#pragma unroll
    for (int r = 0; r < 16; ++r) { p1[r] = ex2(p1[r] - mn); ps += p1[r]; p3[r] = ex2(p3[r] - mn); ps2 += p3[r]; }
    ps = xhalf_sum(ps + ps2);
    l = l * alpha + ps; return alpha;
}
template <int NO> __device__ __forceinline__ void row_scale(f32x16 (&o)[NO], float f, LAS float* al, int r32, int hi) {
    if (hi == 0) al[r32] = f;
    LDS_WAIT();
#pragma unroll
    for (int r = 0; r < 16; ++r) { const float a = al[crow(r, hi)];
#pragma unroll
        for (int d = 0; d < NO; ++d) o[d][r] *= a; }
    LDS_WAIT();
}
struct Stg2 { bf16x8 a, b; };
__device__ __forceinline__ void stg_store_k(LAS char* buf, const Stg2& s, int sr, int sc) { *(LAS bf16x8*)(buf + KSWZ(sr, sc * 2)) = s.a; *(LAS bf16x8*)(buf + KSWZ(32 + sr, sc * 2)) = s.b; }
__device__ __forceinline__ void stg_store_v(LAS char* buf, const Stg2& s, int sr, int sc) { *(LAS bf16x8*)(buf + v_st(sr, sc)) = s.a; *(LAS bf16x8*)(buf + v_st(32 + sr, sc)) = s.b; }

__device__ __forceinline__ void k_slot(int s, int& row, int& col) { row = s >> 4; col = ((s & 15) ^ (row & 7)) * 8; }
__device__ __forceinline__ void v_slot(int s, int& row, int& col) { const int sub = s >> 5, w32 = s & 31, kk = (sub >> 2) * 8 + (w32 >> 2); col = (sub & 3) * 32 + (w32 & 3) * 8; row = (kk & ~0xC) | ((kk & 4) << 1) | ((kk & 8) >> 1); }
__device__ __forceinline__ void glds16(const bf16* g, LAS char* l) { __builtin_amdgcn_global_load_lds((const unsigned*)g, (LAS unsigned*)l, 16, 0, 0); }
#define WAIT_VM(n) asm volatile("s_waitcnt vmcnt(" #n ")" ::: "memory")
#define WG_BAR() do { asm volatile("s_waitcnt lgkmcnt(0)" ::: "memory"); __builtin_amdgcn_s_barrier(); asm volatile("" ::: "memory"); } while (0)

__device__ __forceinline__ float alibi_slope(int h, int nh) { return exp2f(-8.f * (float)(h + 1) / (float)nh); }

__device__ __forceinline__ void diffattn_unit(LAS char* lds, const bf16* __restrict__ proj, bf16* __restrict__ heads, const float* __restrict__ hng, float lam, float hscale, const float* __restrict__ nrm, int nblk,
                                              int b, int h, int qb) {
    int tid_ = threadIdx.x; asm volatile("" : "+v"(tid_)); const int tid = tid_, wid = __builtin_amdgcn_readfirstlane(tid >> 6), lane = tid & 63, r32 = lane & 31, hi = lane >> 5;
    const int st = wid >> 2, rg = wid & 3;
    LAS float* al = (LAS float*)(lds + 132096) + wid * 64;
    const size_t rowbase = (size_t)b * T;
    const int Q0 = qb * 128, q0w = Q0 + rg * 32, qpos = q0w + r32;
    const float sl2 = alibi_slope(h, BH) * LOG2E;
    int j_lo, j_hi;
    {   float m0 = 0.f, m1 = 0.f, m2 = 0.f, m3 = 0.f;
        for (int k = lane; k < nblk; k += 64) { const float* p = nrm + (size_t)k * 64 + b * 16 + h * 2; m0 = fmaxf(m0, p[0]); m1 = fmaxf(m1, p[1]); m2 = fmaxf(m2, p[8]); m3 = fmaxf(m3, p[9]); }
#pragma unroll
        for (int o = 1; o < 64; o <<= 1) { m0 = fmaxf(m0, __shfl_xor(m0, o)); m1 = fmaxf(m1, __shfl_xor(m1, o)); m2 = fmaxf(m2, __shfl_xor(m2, o)); m3 = fmaxf(m3, __shfl_xor(m3, o)); }
        const float B = 1.01f * sqrtf(fmaxf(m0 * m2, m1 * m3)) + 0.01f;
        const float dskip = (2.f * B + 42.f) / sl2;
        const float x = ((float)(Q0 - 63) - dskip) * (1.f / 64.f), y = ((float)(Q0 + 127) + dskip) * (1.f / 64.f);
        j_lo = x <= 0.f ? 0 : (int)ceilf(x); j_hi = y >= (float)(T / 64 - 1) ? T / 64 - 1 : (int)floorf(y);
        j_lo = __builtin_amdgcn_readfirstlane(j_lo); j_hi = __builtin_amdgcn_readfirstlane(j_hi);
    }
    bf16x8 qr[4];
    { const bf16* qp = proj + (rowbase + qpos) * INWP + PB_Q + h * 128 + st * 64 + hi * 8;
#pragma unroll
      for (int d0 = 0; d0 < 4; ++d0) qr[d0] = *(const bf16x8*)(qp + d0 * 16); }
    const bf16* ksrc[2]; const bf16* vsrc[2];
#pragma unroll
    for (int i = 0; i < 2; ++i) { int rw, cl; k_slot((i * 8 + wid) * 64 + lane, rw, cl); ksrc[i] = proj + (rowbase + rw) * INWP + PB_K + h * 128 + cl;
        v_slot((i * 8 + wid) * 64 + lane, rw, cl); vsrc[i] = proj + (rowbase + rw) * INWP + PB_V + h * 128 + cl; }
    LAS char* Vb = lds + 65536;
    const int vb0 = lds_addr(Vb) + v_rd_base(lane);
    int ka[4];
#pragma unroll
    for (int d0 = 0; d0 < 4; ++d0) ka[d0] = lds_addr(lds) + KSWZ(r32, st * 128 + (d0 * 16 + hi * 8) * 2);
#define B_ISSUE(tile, buf) do { const size_t ro_ = (size_t)(tile) * 64 * INWP; LAS char* kd_ = lds + (buf) * 16384 + wid * 1024; LAS char* vd_ = Vb + (buf) * 16384 + wid * 1024; \
        glds16(ksrc[0] + ro_, kd_); glds16(ksrc[1] + ro_, kd_ + 8192); glds16(vsrc[0] + ro_, vd_); glds16(vsrc[1] + ro_, vd_ + 8192); } while (0)
#define B_BIAS(P0, P1, J) do { const float dqh_ = (float)(qpos - (J) * 64 - 4 * hi); \
        if ((J) * 64 + 63 < q0w) { const float Lh_ = -sl2 * dqh_;        \
            _Pragma("unroll") for (int r = 0; r < 16; ++r) { const float c0 = (float)((r & 3) + 8 * (r >> 2)); P0[r] = fmaf(sl2, c0, Lh_); P1[r] = fmaf(sl2, c0 + 32.f, Lh_); } } \
        else if ((J) * 64 > q0w + 31) { const float Lh_ = sl2 * dqh_;    \
            _Pragma("unroll") for (int r = 0; r < 16; ++r) { const float c0 = (float)((r & 3) + 8 * (r >> 2)); P0[r] = fmaf(-sl2, c0, Lh_); P1[r] = fmaf(-sl2, c0 + 32.f, Lh_); } } \
        else { _Pragma("unroll") for (int r = 0; r < 16; ++r) { const float c0 = (float)((r & 3) + 8 * (r >> 2)); P0[r] = -sl2 * fabsf(dqh_ - c0); P1[r] = -sl2 * fabsf(dqh_ - 32.f - c0); } } } while (0)
    float l = 0.f; f32x16 o[4];
#pragma unroll
    for (int d = 0; d < 4; ++d)
#pragma unroll
        for (int r = 0; r < 16; ++r) o[d][r] = 0.f;
    const int nt = j_hi - j_lo + 1;
    asm volatile("" :: "v"(qr[0]), "v"(qr[1]), "v"(qr[2]), "v"(qr[3]));
    B_ISSUE(j_lo, 0);
    if (nt > 1) B_ISSUE(j_lo + 1, 1);
    if (nt > 2) B_ISSUE(j_lo + 2, 2);
    f32x16 pc0, pc1;
    if (nt > 2) WAIT_VM(8); else if (nt > 1) WAIT_VM(4); else WAIT_VM(0);
    WG_BAR();
    B_BIAS(pc0, pc1, j_lo);
    qkt_asm<4>(pc0, pc1, ka, 0, qr);
    int bs = 0;
    for (int t = 0; t < nt; ++t) {
        const int j = j_lo + t, bn = (bs + 1) & 3;
        if (t + 1 < nt) { if (t + 2 < nt) WAIT_VM(4); else WAIT_VM(0); }
        WG_BAR();
        if (t + 3 < nt) B_ISSUE(j + 3, (bs + 3) & 3);
        f32x16 pn0, pn1;
        if (t + 1 < nt) { B_BIAS(pn0, pn1, j + 1); qkt_asm<4>(pn0, pn1, ka, bn * 16384, qr); }
        SBAR();
        float ps = 0.f;
#pragma unroll
        for (int r = 0; r < 16; ++r) { pc0[r] = ex2(pc0[r]); ps += pc0[r]; }
#pragma unroll
        for (int r = 0; r < 16; ++r) { pc1[r] = ex2(pc1[r]); ps += pc1[r]; }
        l += ps;
        const bf16x8 pa0 = pk4<0>(pc0), pa1 = pk4<8>(pc0), pa2 = pk4<0>(pc1), pa3 = pk4<8>(pc1);
        SBAR();
        const int vb = vb0 + bs * 16384;
        pv_one<0>(o[0], vb, pa0, pa1, pa2, pa3); pv_one<1>(o[1], vb, pa0, pa1, pa2, pa3); pv_one<2>(o[2], vb, pa0, pa1, pa2, pa3); pv_one<3>(o[3], vb, pa0, pa1, pa2, pa3);
        if (t + 1 < nt) { pc0 = pn0; pc1 = pn1; }
        bs = bn;
    }
#undef B_ISSUE
#undef B_BIAS
    WG_BAR();
    l = xhalf_sum(l);
    row_scale<4>(o, (st ? lam : 1.f) / l, al, r32, hi);
    LAS float* X = (LAS float*)lds + rg * 4096;
    if (st == 1) {
#pragma unroll
        for (int d = 0; d < 4; ++d)
#pragma unroll
            for (int r = 0; r < 16; ++r) X[crow(r, hi) * 128 + d * 32 + r32] = o[d][r];
    }
    __syncthreads();
    if (st == 0) {
        float g[4];
#pragma unroll
        for (int d = 0; d < 4; ++d) g[d] = hng[(AH + h) * 128 + d * 32 + r32] * hscale;
#pragma unroll
        for (int r = 0; r < 16; ++r) { float ss = 0.f;
#pragma unroll
            for (int d = 0; d < 4; ++d) { o[d][r] -= X[crow(r, hi) * 128 + d * 32 + r32]; ss += o[d][r] * o[d][r]; }
            ss += __shfl_xor(ss, 1); ss += __shfl_xor(ss, 2); ss += __shfl_xor(ss, 4); ss += __shfl_xor(ss, 8); ss += __shfl_xor(ss, 16);
            const float rs = __builtin_amdgcn_rsqf(ss * (1.f / 128.f) + EPS);
            bf16* hp = heads + (rowbase + qb * 128 + rg * 32 + crow(r, hi)) * DM + (AH + h) * 128 + r32;
#pragma unroll
            for (int d = 0; d < 4; ++d) hp[d * 32] = (bf16)f2bf(o[d][r] * rs * g[d]); }
    }
    __syncthreads();
}

__device__ __forceinline__ void dilattn_unit(LAS char* lds, const bf16* __restrict__ proj, bf16* __restrict__ og, float* __restrict__ lse, int b, int h, int cfg, int rho, int seg, int mode = 0) {
    int tid_ = threadIdx.x; asm volatile("" : "+v"(tid_)); const int tid = tid_, wid = __builtin_amdgcn_readfirstlane(tid >> 6), lane = tid & 63, r32 = lane & 31, hi = lane >> 5;
    const int rsh = 2 * cfg, rr = 1 << rsh, nsub = T >> rsh;
    LAS char* Vb = lds + 65536; LAS float* al = (LAS float*)(lds + 132096) + wid * 64;
    const size_t rowbase = (size_t)b * T;
    const int base = seg * 256, qn = base + wid * 32 + r32, qblk = wid >> 1;
    const int qtok = qn * rr + rho;
    bf16x8 qr[8];
    { const bf16* qp = proj + (rowbase + qtok) * INWP + PA_Q + h * 128 + hi * 8;
#pragma unroll
      for (int d0 = 0; d0 < 8; ++d0) qr[d0] = *(const bf16x8*)(qp + d0 * 16); }
    int krow[2], vrow[2]; const bf16* kcolp[2]; const bf16* vcolp[2];
#pragma unroll
    for (int i = 0; i < 2; ++i) { int rw, cl; k_slot((i * 8 + wid) * 64 + lane, rw, cl); krow[i] = rw; kcolp[i] = proj + rowbase * INWP + PA_K + h * 128 + cl;
        v_slot((i * 8 + wid) * 64 + lane, rw, cl); vrow[i] = rw; vcolp[i] = proj + rowbase * INWP + PA_V + h * 128 + cl; }
#define DIL_ISSUE(kt, buf) do { const int k00_ = base + 64 * ((kt) - 1); \
        _Pragma("unroll") for (int i = 0; i < 2; ++i) { int kk_ = k00_ + krow[i]; kk_ = kk_ < 0 ? 0 : (kk_ >= nsub ? nsub - 1 : kk_); glds16(kcolp[i] + (size_t)(kk_ * rr + rho) * INWP, lds + (buf) * 16384 + (i * 8 + wid) * 1024); } \
        _Pragma("unroll") for (int i = 0; i < 2; ++i) { int kk_ = k00_ + vrow[i]; kk_ = kk_ < 0 ? 0 : (kk_ >= nsub ? nsub - 1 : kk_); glds16(vcolp[i] + (size_t)(kk_ * rr + rho) * INWP, Vb + (buf) * 16384 + (i * 8 + wid) * 1024); } } while (0)
    const int vb0 = lds_addr(Vb) + v_rd_base(lane);
    int ka[8];
#pragma unroll
    for (int d0 = 0; d0 < 8; ++d0) ka[d0] = lds_addr(lds) + KSWZ(r32, (d0 * 16 + hi * 8) * 2);
    float m = -1e30f, l = 0.f; f32x16 o[4];
#pragma unroll
    for (int d = 0; d < 4; ++d)
#pragma unroll
        for (int r = 0; r < 16; ++r) o[d][r] = 0.f;
    const float sl2 = alibi_slope(h, AH) * LOG2E * (float)rr;
    asm volatile("" :: "v"(qr[0]), "v"(qr[1]), "v"(qr[2]), "v"(qr[3]), "v"(qr[4]), "v"(qr[5]), "v"(qr[6]), "v"(qr[7]));
    DIL_ISSUE(0, 0); DIL_ISSUE(1, 1); DIL_ISSUE(2, 2); DIL_ISSUE(3, 3);
#define DIL_SCORE(P0, P1, kt) do { const float dqh_ = (float)(qn - (base + 64 * ((kt) - 1)) - 4 * hi); const int rel_ = (kt) - qblk; \
        if (rel_ == 1) { _Pragma("unroll") for (int r = 0; r < 16; ++r) { const float c0 = (float)((r & 3) + 8 * (r >> 2)); P0[r] = -sl2 * fabsf(dqh_ - c0); P1[r] = -sl2 * fabsf(dqh_ - 32.f - c0); } } \
        else if (rel_ == 0) { _Pragma("unroll") for (int r = 0; r < 16; ++r) { const float c0 = (float)((r & 3) + 8 * (r >> 2)); const float d0v = dqh_ - c0, d1v = dqh_ - 32.f - c0; \
            P0[r] = d0v <= 64.f ? -sl2 * d0v : -INFINITY; P1[r] = d1v <= 64.f ? -sl2 * d1v : -INFINITY; } } \
        else { _Pragma("unroll") for (int r = 0; r < 16; ++r) { const float c0 = (float)((r & 3) + 8 * (r >> 2)); const float d0v = dqh_ - c0, d1v = dqh_ - 32.f - c0; \
            P0[r] = d0v >= -64.f ? sl2 * d0v : -INFINITY; P1[r] = d1v >= -64.f ? sl2 * d1v : -INFINITY; } } \
        { int k4[4] = {ka[0], ka[1], ka[2], ka[3]}; qkt_asm<4>(P0, P1, k4, ((kt) & 3) * 16384, qr); } \
        { int k4[4] = {ka[4], ka[5], ka[6], ka[7]}; qkt_asm<4>(P0, P1, k4, ((kt) & 3) * 16384, qr + 4); } } while (0)
#define DIL_PV(P0, P1, kt) do { const bf16x8 pa0 = pk4<0>(P0), pa1 = pk4<8>(P0), pa2 = pk4<0>(P1), pa3 = pk4<8>(P1); const int vb = vb0 + ((kt) & 3) * 16384; \
        pv_one<0>(o[0], vb, pa0, pa1, pa2, pa3); pv_one<1>(o[1], vb, pa0, pa1, pa2, pa3); pv_one<2>(o[2], vb, pa0, pa1, pa2, pa3); pv_one<3>(o[3], vb, pa0, pa1, pa2, pa3); } while (0)
#define DIL_STEP(s) do { const int ta = 2 * (s), tb = 2 * (s) + 1; const int ka0_ = base + 64 * (ta - 1), kb0_ = ka0_ + 64; \
        const bool ua = ta >= qblk && ta <= qblk + 2 && ka0_ >= 0 && ka0_ < nsub, ub = tb >= qblk && tb <= qblk + 2 && kb0_ >= 0 && kb0_ < nsub; \
        if (ua && ub) { f32x16 p0, p1, p2, p3; DIL_SCORE(p0, p1, ta); DIL_SCORE(p2, p3, tb); \
            const float alpha = sm_update2(p0, p1, p2, p3, m, l); if (__any(alpha < 1.f)) row_scale<4>(o, alpha, al, r32, hi); \
            DIL_PV(p0, p1, ta); DIL_PV(p2, p3, tb); } \
        else if (ua || ub) { const int kt = ua ? ta : tb; f32x16 p0, p1; DIL_SCORE(p0, p1, kt); \
            const float alpha = sm_update(p0, p1, m, l); if (__any(alpha < 1.f)) row_scale<4>(o, alpha, al, r32, hi); \
            DIL_PV(p0, p1, kt); } } while (0)
    if (mode == 1) { WAIT_VM(0); WG_BAR(); return; }
    WAIT_VM(8); WG_BAR(); DIL_STEP(0);
    WAIT_VM(0); WG_BAR(); DIL_ISSUE(4, 0); DIL_ISSUE(5, 1); DIL_STEP(1);
    WAIT_VM(0); WG_BAR(); DIL_STEP(2);
#undef DIL_STEP
#undef DIL_PV
#undef DIL_SCORE
#undef DIL_ISSUE
    WG_BAR();
    row_scale<4>(o, 1.f / l, al, r32, hi);
    if (mode == 2) { if (l == 1.2345e30f) og[0] = 0; return; }
    if (hi == 0) lse[((size_t)cfg * M + rowbase + qtok) * AH + h] = (m + __log2f(l)) * LN2;
    bf16* ob = og + ((size_t)cfg * M + rowbase) * (AH * HD) + h * 128 + r32;
#pragma unroll
    for (int r = 0; r < 16; ++r) { const int tok = (base + wid * 32 + crow(r, hi)) * rr + rho;
#pragma unroll
        for (int d = 0; d < 4; ++d) ob[(size_t)tok * (AH * HD) + d * 32] = (bf16)f2bf(o[d][r]); }
}

__device__ __forceinline__ void xattn_unit(LAS char* lds, const bf16* __restrict__ xq, const bf16* __restrict__ kv, bf16* __restrict__ xa, int b, int h, int qb) {
    int tid_ = threadIdx.x; asm volatile("" : "+v"(tid_)); const int tid = tid_, wid = __builtin_amdgcn_readfirstlane(tid >> 6), lane = tid & 63, r32 = lane & 31, hi = lane >> 5;
    LAS char* Kb = lds; LAS char* Vb = lds + 32768; LAS float* al = (LAS float*)(lds + 65536) + wid * 64;
    const size_t row = (size_t)b * T + qb * 256 + wid * 32 + r32;
    const int sr = tid >> 4, sc = (tid & 15) * 8;
    const bf16* kbase = kv + ((size_t)b * MEML + sr) * (2 * DM) + h * XHD + sc;
    const bf16* vbase = kbase + DM;
    const bf16* qp = xq + row * DM + h * XHD + hi * 8;
    f32x16 s[4][2];
#pragma unroll
    for (int t = 0; t < 4; ++t)
#pragma unroll
        for (int r = 0; r < 16; ++r) { s[t][0][r] = 0.f; s[t][1][r] = 0.f; }
    Stg2 sg;
    sg.a = *(const bf16x8*)(kbase); sg.b = *(const bf16x8*)(kbase + (size_t)32 * 2 * DM);
    stg_store_k(Kb, sg, sr, sc);
    __syncthreads();
    bf16x8 qr[8];
#pragma unroll
    for (int i = 0; i < 16; ++i) { const int dc = i >> 2, kt = i & 3;
        if (kt == 0) {
#pragma unroll
            for (int d0 = 0; d0 < 8; ++d0) qr[d0] = *(const bf16x8*)(qp + dc * 128 + d0 * 16); }
        if (i + 1 < 16) { const int dc2 = (i + 1) >> 2, kt2 = (i + 1) & 3; const bf16* p = kbase + (size_t)(kt2 * 64) * 2 * DM + dc2 * 128; sg.a = *(const bf16x8*)p; sg.b = *(const bf16x8*)(p + (size_t)32 * 2 * DM); }
        qkt<8, false>(s[kt][0], s[kt][1], Kb + (i & 1) * 16384, qr, 0, r32, hi);
        if (i + 1 < 16) stg_store_k(Kb + ((i + 1) & 1) * 16384, sg, sr, sc);
        __syncthreads();
    }
    float mx = s[0][0][0];
#pragma unroll
    for (int t = 0; t < 4; ++t)
#pragma unroll
        for (int r = 0; r < 16; ++r) { mx = fmaxf(mx, s[t][0][r]); mx = fmaxf(mx, s[t][1][r]); }
    mx = xhalf_max(mx);
    float ps = 0.f;
#pragma unroll
    for (int t = 0; t < 4; ++t)
#pragma unroll
        for (int r = 0; r < 16; ++r) { s[t][0][r] = ex2(s[t][0][r] - mx); ps += s[t][0][r]; s[t][1][r] = ex2(s[t][1][r] - mx); ps += s[t][1][r]; }
    ps = xhalf_sum(ps);
    bf16x8 pa[4][4];
#pragma unroll
    for (int t = 0; t < 4; ++t) { pa[t][0] = pk4<0>(s[t][0]); pa[t][1] = pk4<8>(s[t][0]); pa[t][2] = pk4<0>(s[t][1]); pa[t][3] = pk4<8>(s[t][1]); }
    if (hi == 0) al[r32] = 1.f / ps;
    LDS_WAIT();
    float rl[16];
#pragma unroll
    for (int r = 0; r < 16; ++r) rl[r] = al[crow(r, hi)];
    const int vb0 = lds_addr(Vb) + v_rd_base(lane);
    sg.a = *(const bf16x8*)(vbase); sg.b = *(const bf16x8*)(vbase + (size_t)32 * 2 * DM);
    stg_store_v(Vb, sg, sr, sc);
    __syncthreads();
    f32x16 o[4];
#pragma unroll
    for (int i = 0; i < 16; ++i) { const int vc = i >> 2, kt = i & 3;
        if (kt == 0) {
#pragma unroll
            for (int d = 0; d < 4; ++d)
#pragma unroll
                for (int r = 0; r < 16; ++r) o[d][r] = 0.f; }
        if (i + 1 < 16) { const int vc2 = (i + 1) >> 2, kt2 = (i + 1) & 3; const bf16* p = vbase + (size_t)(kt2 * 64) * 2 * DM + vc2 * 128; sg.a = *(const bf16x8*)p; sg.b = *(const bf16x8*)(p + (size_t)32 * 2 * DM); }
        const int vb = vb0 + (i & 1) * 16384;
        pv_one<0>(o[0], vb, pa[kt][0], pa[kt][1], pa[kt][2], pa[kt][3]); pv_one<1>(o[1], vb, pa[kt][0], pa[kt][1], pa[kt][2], pa[kt][3]);
        pv_one<2>(o[2], vb, pa[kt][0], pa[kt][1], pa[kt][2], pa[kt][3]); pv_one<3>(o[3], vb, pa[kt][0], pa[kt][1], pa[kt][2], pa[kt][3]);
        if (kt == 3) {
            bf16* op = xa + ((size_t)b * T + qb * 256 + wid * 32) * DM + h * XHD + vc * 128 + r32;
#pragma unroll
            for (int r = 0; r < 16; ++r)
#pragma unroll
                for (int d = 0; d < 4; ++d) op[(size_t)crow(r, hi) * DM + d * 32] = (bf16)f2bf(o[d][r] * rl[r]);
        }
        if (i + 1 < 16) stg_store_v(Vb + ((i + 1) & 1) * 16384, sg, sr, sc);
        __syncthreads();
    }
}

__device__ __forceinline__ void mlstm_dc_unit(LAS char* lds, const bf16* __restrict__ cqk, const bf16* __restrict__ proj, const float* __restrict__ GA, const LAS float* ML,
                                              bf16* __restrict__ dC, float* __restrict__ dn, int b, int h, int c) {
    int tid_ = threadIdx.x; asm volatile("" : "+v"(tid_)); const int tid = tid_, wid = __builtin_amdgcn_readfirstlane(tid >> 6), lane = tid & 63, r32 = lane & 31, hi = lane >> 5;
    const int bh = b * CH + h;
    LAS char* KF = lds; LAS char* KB = lds + 32768; LAS char* VV = lds + 65536;
    const int sr = tid >> 4, sc = (tid & 15) * 8;
    const float mlf = ML[(0 * 24 + bh) * NCH + c], mlb = ML[(1 * 24 + bh) * NCH + c];
#pragma unroll
    for (int q = 0; q < 4; ++q) { const int s = q * 32 + sr; const size_t m = (size_t)b * T + c * LC + s;
        const bf16x8 kk = *(const bf16x8*)(cqk + m * 1536 + 768 + h * 128 + sc);
        const bf16x8 vv = *(const bf16x8*)(proj + m * INWP + PC_V + h * 128 + sc);
        const float gwf = ex2((GA[(size_t)(0 * 24 + bh) * T + c * LC + s] - mlf) * LOG2E), gwb = ex2((GA[(size_t)(1 * 24 + bh) * T + c * LC + s] - mlb) * LOG2E);
        const int off = (q >> 1) * 16384 + v_st((q & 1) * 32 + sr, sc);
        *(LAS bf16x8*)(KF + off) = scale8(kk, gwf); *(LAS bf16x8*)(KB + off) = scale8(kk, gwb); *(LAS bf16x8*)(VV + off) = vv; }
    __syncthreads();
    const int dir = wid >> 2, dk0 = wid & 3;
    const int va = lds_addr(dir ? KB : KF) + v_rd_base(lane) + dk0 * 512, vv0 = lds_addr(VV) + v_rd_base(lane);
    f32x16 acc[4], accn;
#pragma unroll
    for (int r = 0; r < 16; ++r) { acc[0][r] = 0.f; acc[1][r] = 0.f; acc[2][r] = 0.f; acc[3][r] = 0.f; accn[r] = 0.f; }
    const bf16x8 ones = {0x3F80, 0x3F80, 0x3F80, 0x3F80, 0x3F80, 0x3F80, 0x3F80, 0x3F80};
#define DC_STEP(t, ks) do { const s16x4 al_ = tr_read<(t) * 16384 + v_rd_off(0, ks, 0)>(va), ah_ = tr_read<(t) * 16384 + v_rd_off(0, ks, 1)>(va); \
        const s16x4 b0l = tr_read<(t) * 16384 + v_rd_off(0, ks, 0)>(vv0), b0h = tr_read<(t) * 16384 + v_rd_off(0, ks, 1)>(vv0), b1l = tr_read<(t) * 16384 + v_rd_off(1, ks, 0)>(vv0), b1h = tr_read<(t) * 16384 + v_rd_off(1, ks, 1)>(vv0); \
        const s16x4 b2l = tr_read<(t) * 16384 + v_rd_off(2, ks, 0)>(vv0), b2h = tr_read<(t) * 16384 + v_rd_off(2, ks, 1)>(vv0), b3l = tr_read<(t) * 16384 + v_rd_off(3, ks, 0)>(vv0), b3h = tr_read<(t) * 16384 + v_rd_off(3, ks, 1)>(vv0); \
        asm volatile("s_waitcnt lgkmcnt(0)" ::: "memory"); SBAR(); const bf16x8 A_ = PK8(al_, ah_); \
        acc[0] = __builtin_amdgcn_mfma_f32_32x32x16_bf16(A_, PK8(b0l, b0h), acc[0], 0, 0, 0); acc[1] = __builtin_amdgcn_mfma_f32_32x32x16_bf16(A_, PK8(b1l, b1h), acc[1], 0, 0, 0); \
        acc[2] = __builtin_amdgcn_mfma_f32_32x32x16_bf16(A_, PK8(b2l, b2h), acc[2], 0, 0, 0); acc[3] = __builtin_amdgcn_mfma_f32_32x32x16_bf16(A_, PK8(b3l, b3h), acc[3], 0, 0, 0); \
        accn = __builtin_amdgcn_mfma_f32_32x32x16_bf16(A_, ones, accn, 0, 0, 0); } while (0)
    DC_STEP(0, 0); DC_STEP(0, 1); DC_STEP(0, 2); DC_STEP(0, 3); DC_STEP(1, 0); DC_STEP(1, 1); DC_STEP(1, 2); DC_STEP(1, 3);
#undef DC_STEP
    bf16* dp = dC + ((size_t)(dir * 24 + bh) * NCH + c) * (LC * HD) + (size_t)(dk0 * 32) * HD + r32;
#pragma unroll
    for (int r = 0; r < 16; ++r)
#pragma unroll
        for (int d = 0; d < 4; ++d) dp[(size_t)crow(r, hi) * HD + d * 32] = (bf16)f2bf(acc[d][r]);
    if (r32 == 0) { float* np = dn + ((size_t)(dir * 24 + bh) * NCH + c) * HD + dk0 * 32;
#pragma unroll
        for (int r = 0; r < 16; ++r) np[crow(r, hi)] = accn[r]; }
    __syncthreads();
}

constexpr int SM_OFF = 132096;
__device__ __forceinline__ void mlstm_out_unit(LAS char* lds, const bf16* __restrict__ cqk, const bf16* __restrict__ proj, const float* __restrict__ GA, const float* __restrict__ GM, const float* __restrict__ GB,
                                               const float* __restrict__ MS, const bf16* __restrict__ Cst, const float* __restrict__ nst, bf16* __restrict__ heads, const float* __restrict__ hng, int b, int h, int c) {
    int tid_ = threadIdx.x; asm volatile("" : "+v"(tid_)); const int tid = tid_, wid = __builtin_amdgcn_readfirstlane(tid >> 6), lane = tid & 63, r32 = lane & 31, hi = lane >> 5;
#define OUT_TS(i)
    OUT_TS(0);
    const int bh = b * CH + h, rg = wid & 3, ch = wid >> 2;
    LAS char* KK = lds; LAS char* VV = lds + 32768; LAS char* CF = lds + 65536; LAS char* CB = lds + 98304;
    LAS float* SM = (LAS float*)(lds + SM_OFF);
    const int sr = tid >> 4, sc = (tid & 15) * 8;
    const size_t m0 = (size_t)b * T + c * LC;
    const size_t seqf = (size_t)(0 * 24 + bh), seqb = (size_t)(1 * 24 + bh);
    const bf16* cfp = Cst + (seqf * NCH + c) * (LC * HD); const bf16* cbp = Cst + (seqb * NCH + c) * (LC * HD);
#pragma unroll
    for (int q = 0; q < 4; ++q) { const int s = q * 32 + sr;
        const bf16x8 kk = *(const bf16x8*)(cqk + (m0 + s) * 1536 + 768 + h * 128 + sc);
        const bf16x8 vv = *(const bf16x8*)(proj + (m0 + s) * INWP + PC_V + h * 128 + sc);
        const bf16x8 cf = *(const bf16x8*)(cfp + (size_t)s * HD + sc);
        const bf16x8 cb = *(const bf16x8*)(cbp + (size_t)s * HD + sc);
        *(LAS bf16x8*)(KK + (q >> 1) * 16384 + KSWZ((q & 1) * 32 + sr, sc * 2)) = kk;
        const int off = (q >> 1) * 16384 + v_st((q & 1) * 32 + sr, sc);
        *(LAS bf16x8*)(VV + off) = vv; *(LAS bf16x8*)(CF + off) = cf; *(LAS bf16x8*)(CB + off) = cb; }
    if (tid < 128) { SM[tid] = GA[seqf * T + c * LC + tid] * LOG2E; SM[128 + tid] = GA[seqb * T + c * LC + tid] * LOG2E; SM[256 + tid] = nst[(seqf * NCH + c) * HD + tid]; SM[384 + tid] = nst[(seqb * NCH + c) * HD + tid]; }
    const int i = rg * 32 + r32;
    bf16x8 qr[8];
    { const bf16* qp = cqk + (m0 + i) * 1536 + h * 128 + hi * 8;
#pragma unroll
      for (int d0 = 0; d0 < 8; ++d0) qr[d0] = *(const bf16x8*)(qp + d0 * 16); }
    const float msf = MS[seqf * NCH + c], msb = MS[seqb * NCH + c];
    const float Mf = fmaxf(msf, GM[seqf * T + c * LC + i]), Mb = fmaxf(msb, GM[seqb * T + c * LC + i]), bcf = GB[seqf * T + c * LC + i], bcb = GB[seqb * T + c * LC + i];
    __syncthreads();
    OUT_TS(1);
    f32x16 p[2][2];
    qkt<8, true>(p[0][0], p[0][1], KK, qr, 0, r32, hi);
    qkt<8, true>(p[1][0], p[1][1], KK + 16384, qr, 0, r32, hi);
    float qnf = 0.f, qnb = 0.f;
#pragma unroll
    for (int d0 = 0; d0 < 8; ++d0) {
#pragma unroll
        for (int j = 0; j < 8; ++j) { const float qv = bf2f((unsigned short)qr[d0][j]); const int dim = d0 * 16 + hi * 8 + j; qnf = fmaf(qv, SM[256 + dim], qnf); qnb = fmaf(qv, SM[384 + dim], qnb); }
        SBAR(); }
    qnf = xhalf_sum(qnf); qnb = xhalf_sum(qnb);
    const float MfL = Mf * LOG2E, MbL = Mb * LOG2E, tb = (float)(4 * hi - i);
    float rsf = 0.f, rsb = 0.f;
#define OUT_P1(t, hf) do { const int kb_ = 2 * (t) + (hf); \
        if (kb_ < rg) { _Pragma("unroll") for (int r = 0; r < 16; ++r) { const int jc = (t) * 64 + (hf) * 32 + (r & 3) + 8 * (r >> 2); const float e_ = ex2(SM[jc + 4 * hi] - MfL); p[t][hf][r] *= e_; rsf += p[t][hf][r]; } } \
        else if (kb_ > rg) { _Pragma("unroll") for (int r = 0; r < 16; ++r) { const int jc = (t) * 64 + (hf) * 32 + (r & 3) + 8 * (r >> 2); const float e_ = ex2(SM[128 + jc + 4 * hi] - MbL); p[t][hf][r] *= e_; rsb += p[t][hf][r]; } } \
        else { _Pragma("unroll") for (int r = 0; r < 16; ++r) { const int jc = (t) * 64 + (hf) * 32 + (r & 3) + 8 * (r >> 2); const float tt = tb + (float)jc; const LAS float* sj = SM + jc + 4 * hi; \
                const float ef = ex2(fmaf(fmaxf(tt, 0.f), -1e30f, sj[0] - MfL)), eb = ex2(fmaf(fmaxf(-tt, 0.f), -1e30f, sj[128] - MbL)); \
                rsf = fmaf(p[t][hf][r], ef, rsf); rsb = fmaf(p[t][hf][r], eb, rsb); } } \
        SBAR(); } while (0)
    OUT_P1(0, 0); OUT_P1(0, 1); OUT_P1(1, 0); OUT_P1(1, 1);
#undef OUT_P1
    rsf = xhalf_sum(rsf); rsb = xhalf_sum(rsb);
    const float iwf = ex2((msf - Mf) * LOG2E), iwb = ex2((msb - Mb) * LOG2E);
    const float denf = fmaf(iwf, qnf, rsf), denb = fmaf(iwb, qnb, rsb);
    const float rf = __builtin_amdgcn_rcpf(fmaxf(fabsf(denf), ex2((-bcf - Mf) * LOG2E))), rb = __builtin_amdgcn_rcpf(fmaxf(fabsf(denb), ex2((-bcb - Mb) * LOG2E)));
    float tb2 = tb; asm volatile("" : "+v"(tb2));
#define OUT_P2(t, hf) do { const int kb_ = 2 * (t) + (hf); \
        if (kb_ < rg) { _Pragma("unroll") for (int r = 0; r < 16; ++r) p[t][hf][r] *= rf; } \
        else if (kb_ > rg) { _Pragma("unroll") for (int r = 0; r < 16; ++r) p[t][hf][r] *= rb; } \
        else { _Pragma("unroll") for (int r = 0; r < 16; ++r) { const int jc = (t) * 64 + (hf) * 32 + (r & 3) + 8 * (r >> 2); const float tt = tb2 + (float)jc; const LAS float* sj = SM + jc + 4 * hi; \
                const float ef = ex2(fmaf(fmaxf(tt, 0.f), -1e30f, sj[0] - MfL)), eb = ex2(fmaf(fmaxf(-tt, 0.f), -1e30f, sj[128] - MbL)); \
                p[t][hf][r] *= fmaf(ef, rf, eb * rb); } } \
        SBAR(); } while (0)
    OUT_P2(0, 0); OUT_P2(0, 1); OUT_P2(1, 0); OUT_P2(1, 1);
#undef OUT_P2
    const float sf = iwf * rf, sb = iwb * rb;
    OUT_TS(2);
    f32x16 o[2];
#pragma unroll
    for (int r = 0; r < 16; ++r) { o[0][r] = 0.f; o[1][r] = 0.f; }
    const int vbv = lds_addr(VV) + v_rd_base(lane) + ch * 1024, vbf = lds_addr(CF) + v_rd_base(lane) + ch * 1024, vbb = lds_addr(CB) + v_rd_base(lane) + ch * 1024;
    {   const bf16x8 a0 = pk4<0>(p[0][0]), a1 = pk4<8>(p[0][0]), a2 = pk4<0>(p[0][1]), a3 = pk4<8>(p[0][1]);
        pv_one<0>(o[0], vbv, a0, a1, a2, a3); pv_one<1>(o[1], vbv, a0, a1, a2, a3); }
    {   const bf16x8 a0 = pk4<0>(p[1][0]), a1 = pk4<8>(p[1][0]), a2 = pk4<0>(p[1][1]), a3 = pk4<8>(p[1][1]);
        pv_one<0>(o[0], vbv + 16384, a0, a1, a2, a3); pv_one<1>(o[1], vbv + 16384, a0, a1, a2, a3); }
    {   const bf16x8 a0 = scale8(qr[0], sf), a1 = scale8(qr[1], sf), a2 = scale8(qr[2], sf), a3 = scale8(qr[3], sf);
        pv_one<0>(o[0], vbf, a0, a1, a2, a3); pv_one<1>(o[1], vbf, a0, a1, a2, a3); }
    {   const bf16x8 a0 = scale8(qr[4], sf), a1 = scale8(qr[5], sf), a2 = scale8(qr[6], sf), a3 = scale8(qr[7], sf);
        pv_one<0>(o[0], vbf + 16384, a0, a1, a2, a3); pv_one<1>(o[1], vbf + 16384, a0, a1, a2, a3); }
    {   const bf16x8 a0 = scale8(qr[0], sb), a1 = scale8(qr[1], sb), a2 = scale8(qr[2], sb), a3 = scale8(qr[3], sb);
        pv_one<0>(o[0], vbb, a0, a1, a2, a3); pv_one<1>(o[1], vbb, a0, a1, a2, a3); }
    {   const bf16x8 a0 = scale8(qr[4], sb), a1 = scale8(qr[5], sb), a2 = scale8(qr[6], sb), a3 = scale8(qr[7], sb);
        pv_one<0>(o[0], vbb + 16384, a0, a1, a2, a3); pv_one<1>(o[1], vbb + 16384, a0, a1, a2, a3); }
    OUT_TS(3);
    const int col0 = ch * 64 + r32;
    float ss[16];
#pragma unroll
    for (int r = 0; r < 16; ++r) { const bf16* gp = proj + (m0 + rg * 32 + crow(r, hi)) * INWP + PC_O + h * 128 + col0; float s2 = 0.f;
#pragma unroll
        for (int d = 0; d < 2; ++d) { const float gate = bf2f(gp[d * 32]); const float v = o[d][r] * __builtin_amdgcn_rcpf(1.f + ex2(-gate * LOG2E)); o[d][r] = v; s2 = fmaf(v, v, s2); }
        s2 += __shfl_xor(s2, 1); s2 += __shfl_xor(s2, 2); s2 += __shfl_xor(s2, 4); s2 += __shfl_xor(s2, 8); s2 += __shfl_xor(s2, 16);
        ss[r] = s2; if (r32 == 0) SM[512 + ch * 128 + rg * 32 + crow(r, hi)] = s2; }
    __syncthreads();
    const float g0 = hng[(AH + BH + h) * 128 + col0], g1 = hng[(AH + BH + h) * 128 + col0 + 32];
#pragma unroll
    for (int r = 0; r < 16; ++r) { const float tot = ss[r] + SM[512 + (ch ^ 1) * 128 + rg * 32 + crow(r, hi)]; const float rs = __builtin_amdgcn_rsqf(tot * (1.f / 128.f) + EPS);
        bf16* hp = heads + (m0 + rg * 32 + crow(r, hi)) * DM + (AH + BH + h) * 128 + col0;
        hp[0] = (bf16)f2bf(o[0][r] * rs * g0); hp[32] = (bf16)f2bf(o[1][r] * rs * g1); }
    __syncthreads();
    OUT_TS(4);
#undef OUT_TS
}

constexpr size_t MiB = 1u << 20;
constexpr size_t WS_CTL = 0, CTL_ZERO_BYTES = 1 * MiB;
constexpr size_t WS_GATES = 1 * MiB;
constexpr size_t GSEQ_BYTES = (size_t)2 * 24 * T * 4;
constexpr size_t WS_GA = 3 * MiB, WS_GM = WS_GA + GSEQ_BYTES, WS_GB = WS_GM + GSEQ_BYTES;
constexpr size_t WS_MS = WS_GB + GSEQ_BYTES, WS_ML = WS_MS + 8192, WS_BL = WS_ML + 8192, WS_AL = WS_BL + 8192, WS_NRM = WS_AL + 8192;
constexpr size_t WS_DN = 6 * MiB;
constexpr size_t WS_LSE = 7 * MiB;
constexpr size_t WS_MEMB = 9 * MiB;
constexpr size_t WS_KV = 13 * MiB;
constexpr size_t WS_W = 22 * MiB;
constexpr size_t W_IN = 0, W_OUT = 28 * MiB, W_XQ = 36 * MiB, W_XKV = 44 * MiB, W_XO = 60 * MiB, W_UP = 68 * MiB, W_DOWN = 100 * MiB;
constexpr size_t WS_ACT0 = 154 * MiB;
constexpr size_t WS_ACT1 = 218 * MiB;
constexpr size_t WS_PROJ = 282 * MiB;
constexpr size_t WS_XRES = 538 * MiB;
constexpr size_t OUT_OG = 0, OUT_DC = 72 * MiB;
constexpr size_t WS_SSP = 626 * MiB;
constexpr size_t WS_END = 628 * MiB;
static_assert(WS_KV + (size_t)1024 * 4096 * 2 <= WS_W && WS_W + 132 * MiB <= WS_ACT0 && WS_PROJ + (size_t)M * INWP * 2 <= WS_XRES && WS_PROJ + (size_t)M * DFF * 2 <= WS_XRES && WS_XRES + (size_t)M * DM * 2 <= WS_SSP, "d_ws map");
static_assert(OUT_OG + (size_t)3 * M * 768 * 2 <= OUT_DC && OUT_DC + (size_t)2 * 24 * 32 * 128 * 128 * 2 <= (size_t)M * DM * 4 && WS_NRM + 65536 <= WS_DN && WS_LSE + (size_t)3 * M * 6 * 4 <= WS_MEMB, "d_ws map 2");
constexpr int CW_TMO = 0, CW_BAR = 4096;
constexpr int RING_OFF = 0, RING_BYTES = 131072, LDSCTL_OFF = RING_BYTES, MISC_OFF = LDSCTL_OFF + 320, LDS_BYTES = 151552;
constexpr int TBL_OFF = 136192;
constexpr int NWAVES = 8;
constexpr int NPH = 15, NPHT = DEPTH * NPH + 1;

#define XB_TMO      128
#define XB_XCNT(j)  (256  + 64 * (j))
#define XB_XSUB(j)  (1280 + 64 * (j))
#define XB_XGEN(j)  (2304 + 64 * (j))
#define XB_TOP      3328
#define XB_TOPGEN   3392
#define XCD_BAR_WORDS 3456
#define XB_SPIN_CAP (1u << 18)

__device__ __forceinline__ unsigned xb_ld(unsigned* p)              { return __hip_atomic_load(p, __ATOMIC_RELAXED, __HIP_MEMORY_SCOPE_AGENT); }
__device__ __forceinline__ unsigned xb_add(unsigned* p, unsigned v) { return __hip_atomic_fetch_add(p, v, __ATOMIC_RELAXED, __HIP_MEMORY_SCOPE_AGENT); }
__device__ __forceinline__ unsigned xb_xcc_id() { return (unsigned)__builtin_amdgcn_s_getreg((3 << 11) | 20) & 0xFu; }
#define XB_SPIN(cond, bar) do { unsigned _sp = 0; while (cond) { __builtin_amdgcn_s_sleep(1); \
    if ((++_sp & 255u) == 0u) { if (xb_ld(&(bar)[XB_TMO])) break; if (_sp > XB_SPIN_CAP) { atomicAdd(&(bar)[XB_TMO], 1u); break; } } } } while (0)

struct XcdBarrier {
    unsigned* bar; unsigned x;
    volatile LAS unsigned* st;
};

__device__ __forceinline__ XcdBarrier xcd_barrier_post(unsigned* bar, volatile LAS unsigned* st) {
    XcdBarrier b; b.bar = bar; b.x = xb_xcc_id(); b.st = st;
    if (threadIdx.x == 0) (void)xb_add(&bar[XB_XCNT(b.x)], 1u);
    return b;
}
__device__ __forceinline__ void xcd_barrier_complete(unsigned* bar, unsigned x, unsigned& nloc, unsigned& nx) {
    const unsigned G = gridDim.x * gridDim.y * gridDim.z;
    unsigned sum, cnt, mine, sp = 0u;
    for (;;) {
        sum = 0u; cnt = 0u; mine = 0u;
#pragma unroll
        for (unsigned j = 0; j < 16; ++j) { const unsigned c = xb_ld(&bar[XB_XCNT(j)]); sum += c; cnt += (c > 0u) ? 1u : 0u; mine = (j == x) ? c : mine; }
        if (sum == G) break;
        __builtin_amdgcn_s_sleep(1);
        if ((++sp & 255u) == 0u) { if (xb_ld(&bar[XB_TMO])) break; if (sp > XB_SPIN_CAP) { atomicAdd(&bar[XB_TMO], 1u); break; } }
    }
    nloc = mine > 0u ? mine : 1u; nx = cnt > 0u ? cnt : 1u;
}

__device__ __forceinline__ void xcd_barrier(const XcdBarrier& b) {
    asm volatile("s_waitcnt vmcnt(0)" ::: "memory");
    __syncthreads();
    if (threadIdx.x == 0) {
        unsigned* bar = b.bar;
        __builtin_amdgcn_s_waitcnt(0);
        unsigned nloc = b.st[0], nx = b.st[1];
        if (nloc == 0u) { xcd_barrier_complete(bar, b.x, nloc, nx); b.st[0] = nloc; b.st[1] = nx; }
        const unsigned old = xb_add(&bar[XB_XSUB(b.x)], 1u);
        const unsigned gen = old / nloc;
        if (old + 1u == (gen + 1u) * nloc) {
            __builtin_amdgcn_fence(__ATOMIC_RELEASE, "agent");
            asm volatile("s_waitcnt vmcnt(0)" ::: "memory");
            const unsigned og = xb_add(&bar[XB_TOP], 1u);
            const unsigned tg = og / nx;
            if (og + 1u == (tg + 1u) * nx) xb_add(&bar[XB_TOPGEN], 1u);
            else XB_SPIN(xb_ld(&bar[XB_TOPGEN]) == tg, bar);
            __builtin_amdgcn_fence(__ATOMIC_ACQUIRE, "agent");
            xb_add(&bar[XB_XGEN(b.x)], 1u);
            asm volatile("s_waitcnt vmcnt(0)" ::: "memory");
        } else {
            XB_SPIN(xb_ld(&bar[XB_XGEN(b.x)]) == gen, bar);
            __builtin_amdgcn_fence(__ATOMIC_ACQUIRE, "agent");
            asm volatile("s_waitcnt vmcnt(0)" ::: "memory");
        }
    }
    __syncthreads();
}

__device__ __forceinline__ float wave_sum(float v) {
#pragma unroll
    for (int o = 1; o < 64; o <<= 1) v += __shfl_xor(v, o);
    return v;
}
__device__ __forceinline__ float wave_incl_sum(float x, int lane) {
#pragma unroll
    for (int o = 1; o < 64; o <<= 1) { const float v = __shfl_up(x, o); if (lane >= o) x += v; }
    return x;
}
__device__ __forceinline__ float wave_incl_max(float x, int lane) {
#pragma unroll
    for (int o = 1; o < 64; o <<= 1) { const float v = __shfl_up(x, o); if (lane >= o) x = fmaxf(x, v); }
    return x;
}
__device__ __forceinline__ void tr_load(float (&v)[32], const float* __restrict__ W, int N, int nblk, int r, int lane) {
    const int kb = r / nblk, nb = r % nblk, k0 = 64 * kb, n0 = 32 * nb;
    const int nn = n0 + (lane & 31); const bool ok = nn < N;
    const float* p = W + (size_t)(k0 + (lane >> 5)) * N + nn;
#pragma unroll
    for (int i = 0; i < 32; ++i) v[i] = ok ? p[(size_t)(2 * i) * N] : 0.f;
}
__device__ __forceinline__ void tr_store(const float (&v)[32], bf16* __restrict__ WT, const float* __restrict__ gain, int K, int nblk, int r, LAS float* scr, int lane, int cs_lo, int cs_hi, float cs_val, int cs2_hi, float cs2_val) {
    const int kb = r / nblk, nb = r % nblk, k0 = 64 * kb, n0 = 32 * nb;
#pragma unroll
    for (int i = 0; i < 32; ++i) scr[(2 * i + (lane >> 5)) * 33 + (lane & 31)] = v[i];
    LDS_WAIT(); asm volatile("" ::: "memory");
    const int c = lane & 7;
    float g[8];
#pragma unroll
    for (int e = 0; e < 8; ++e) g[e] = gain ? gain[k0 + 8 * c + e] : 1.f;
#pragma unroll
    for (int j = 0; j < 4; ++j) { const int n = (lane >> 3) + 8 * j; const LAS float* s = scr + (8 * c) * 33 + n; const float cs = (n0 + n >= cs_lo && n0 + n < cs_hi) ? cs_val : ((n0 + n < cs2_hi) ? cs2_val : 1.f);
        v4u o; o.x = pk2(s[0 * 33] * g[0] * cs, s[1 * 33] * g[1] * cs); o.y = pk2(s[2 * 33] * g[2] * cs, s[3 * 33] * g[3] * cs); o.z = pk2(s[4 * 33] * g[4] * cs, s[5 * 33] * g[5] * cs); o.w = pk2(s[6 * 33] * g[6] * cs, s[7 * 33] * g[7] * cs);
        *(v4u*)(WT + (size_t)(n0 + n) * K + k0 + 8 * c) = o; }
    LDS_WAIT(); asm volatile("" ::: "memory");
}
__device__ __forceinline__ void rownorm_bf16(const float* __restrict__ X, bf16* __restrict__ O, int nrows, int gw, int NGW, int lane) {
    for (int m0 = gw; m0 < nrows; m0 += 2 * NGW) {
        const int m1 = m0 + NGW < nrows ? m0 + NGW : m0;
        const f32x4* xa = (const f32x4*)(X + (size_t)m0 * DM) + lane; const f32x4* xb = (const f32x4*)(X + (size_t)m1 * DM) + lane; f32x4 va[8], vb[8]; float sa = 0.f, sb = 0.f;
#pragma unroll
        for (int j = 0; j < 8; ++j) { va[j] = xa[64 * j]; vb[j] = xb[64 * j]; }
#pragma unroll
        for (int j = 0; j < 8; ++j) { sa += (va[j].x * va[j].x + va[j].y * va[j].y) + (va[j].z * va[j].z + va[j].w * va[j].w); sb += (vb[j].x * vb[j].x + vb[j].y * vb[j].y) + (vb[j].z * vb[j].z + vb[j].w * vb[j].w); }
        const float ra = 1.0f / sqrtf(wave_sum(sa) * (1.f / DM) + EPS), rb = 1.0f / sqrtf(wave_sum(sb) * (1.f / DM) + EPS);
        unsigned long long* oa = (unsigned long long*)(O + (size_t)m0 * DM) + lane; unsigned long long* ob = (unsigned long long*)(O + (size_t)m1 * DM) + lane;
#pragma unroll
        for (int j = 0; j < 8; ++j) oa[64 * j] = (unsigned long long)pk2(va[j].x * ra, va[j].y * ra) | ((unsigned long long)pk2(va[j].z * ra, va[j].w * ra) << 32);
        if (m1 != m0) {
#pragma unroll
            for (int j = 0; j < 8; ++j) ob[64 * j] = (unsigned long long)pk2(vb[j].x * rb, vb[j].y * rb) | ((unsigned long long)pk2(vb[j].z * rb, vb[j].w * rb) << 32); }
    }
}
__device__ __forceinline__ float log_sigmoid(float x) { return fminf(x, 0.f) - log1pf(expf(-fabsf(x))); }

__device__ __forceinline__ void build_rtab(const pg8::StaticOrder& S, const float* __restrict__ ssp, LAS float* rt) {
    int tid_ = threadIdx.x; asm volatile("" : "+v"(tid_)); const int rl = tid_ & 255;
#pragma unroll 1
    for (int i = tid_ >> 8; i < 8; i += 2) { pg8::Unit u; u.pm = 0; u.pn = 0; const bool ok = S.next(i, u); if (!ok) break;
        const f32x4* pp = (const f32x4*)(ssp + (size_t)(u.pm * 256 + rl) * 32); float t = 0.f;
#pragma unroll
        for (int q = 0; q < 8; ++q) { const f32x4 a = pp[q]; t += (a[0] + a[1]) + (a[2] + a[3]); }
        rt[i * 256 + rl] = 1.0f / sqrtf(t * (1.f / DM) + EPS); }
    __syncthreads();
}
struct Args { const float* in[18]; float* out; unsigned char* ws; int ph_lo, ph_hi; };

#ifndef PG8_SP2
#define PG8_SP2 true
#endif
#ifndef PG8_ALIGN
#define PG8_ALIGN true
#endif

__global__ void __launch_bounds__(NWAVES * 64, 2) enc_fwd(Args args) {
    extern __shared__ __attribute__((aligned(16))) unsigned char lds_raw[];
    LAS unsigned char* lds = (LAS unsigned char*)lds_raw;
    volatile LAS unsigned* MISC = (volatile LAS unsigned*)(lds + MISC_OFF);
    const int G = gridDim.x, bx = blockIdx.x;
    const int vcu = (G % 8 == 0) ? (bx % 8) * (G / 8) + bx / 8 : bx;
    const int NGW = G * NWAVES; const size_t NTH = (size_t)G * NWAVES * 64;
#define PH_IDS int ptid_ = threadIdx.x; asm volatile("" : "+v"(ptid_)); const int tid = ptid_, lane = tid & 63, wave = __builtin_amdgcn_readfirstlane(tid >> 6); \
    const int gw = vcu * NWAVES + wave; const size_t gt = (size_t)bx * (NWAVES * 64) + tid; (void)lane; (void)gw; (void)gt;
    unsigned char* ws = args.ws;
    gu32* ctl = (gu32*)(ws + WS_CTL);
    for (int u = threadIdx.x; u < (LDS_BYTES - LDSCTL_OFF) / 4; u += NWAVES * 64) ((LAS unsigned*)(lds + LDSCTL_OFF))[u] = 0u;
    __syncthreads();
    XcdBarrier bar = xcd_barrier_post((unsigned*)(ctl + CW_BAR), MISC + 8);
    const int lo = args.ph_lo, hi_ = args.ph_hi;
#define IN(k) (lo <= (k) && (k) < hi_)
#define BUILD_RTAB(S_) build_rtab(S_, SSP, (LAS float*)(lds + 132096))
#define REPS(k) for (int rep_ = 0; rep_ < (((k) == MK_REP_PHASE) ? MK_REP_N + 1 : 1); ++rep_)
#if MK_TIME_A >= 0 || MK_TIME_B >= 0
    unsigned long long* TS = (unsigned long long*)(ws + WS_CTL + 524288);
    if (bx == 0 && threadIdx.x == 0) TS[63] = __builtin_amdgcn_s_memrealtime();
#define SEAM(k) do { if (IN(k) && IN((k) + 1)) xcd_barrier(bar); if (bx == 0 && threadIdx.x == 0) TS[k] = __builtin_amdgcn_s_memrealtime(); } while (0)
#else
#define SEAM(k) do { if (IN(k) && IN((k) + 1)) xcd_barrier(bar); } while (0)
#endif

    const float* x = args.in[0]; const float* mem = args.in[1]; float* out = args.out;
    float* GATES = (float*)(ws + WS_GATES); float* GA = (float*)(ws + WS_GA); float* GM = (float*)(ws + WS_GM); float* GB = (float*)(ws + WS_GB);
    float* MSa = (float*)(ws + WS_MS); float* MLa = (float*)(ws + WS_ML); float* BLa = (float*)(ws + WS_BL); float* ALa = (float*)(ws + WS_AL); float* NRM = (float*)(ws + WS_NRM); float* SSP = (float*)(ws + WS_SSP); float* DN = (float*)(ws + WS_DN); float* LSE = (float*)(ws + WS_LSE);
    bf16* MEMB = (bf16*)(ws + WS_MEMB); bf16* KV = (bf16*)(ws + WS_KV);
    bf16* Win_t = (bf16*)(ws + WS_W + W_IN); bf16* Wout_t = (bf16*)(ws + WS_W + W_OUT); bf16* Wxq_t = (bf16*)(ws + WS_W + W_XQ); bf16* Wxkv_t = (bf16*)(ws + WS_W + W_XKV);
    bf16* Wxo_t = (bf16*)(ws + WS_W + W_XO); bf16* Wup_t = (bf16*)(ws + WS_W + W_UP); bf16* Wdown_t = (bf16*)(ws + WS_W + W_DOWN);
    bf16* ACT0 = (bf16*)(ws + WS_ACT0); bf16* ACT1 = (bf16*)(ws + WS_ACT1); bf16* CQK = ACT1; bf16* PROJ = (bf16*)(ws + WS_PROJ); bf16* HID = PROJ;
    bf16* OG = (bf16*)((unsigned char*)out + OUT_OG); bf16* DC = (bf16*)((unsigned char*)out + OUT_DC); bf16* XRES = (bf16*)(ws + WS_XRES);

    for (int layer = 0; layer < DEPTH; ++layer) {
        const int pb = layer * NPH;
        const float* norm_mix_g = args.in[2] + (size_t)layer * DM;
        const float* w_in = args.in[3] + (size_t)layer * DM * INW;
        const float* conv_w = args.in[4] + (size_t)layer * 3 * 1536;
        const float* gate_b = args.in[5] + (size_t)layer * 24;
        const float* diff_lambda = args.in[6] + (size_t)layer * 256;
        const float* head_norm_g = args.in[7] + (size_t)layer * DM;
        const float* w_out = args.in[8] + (size_t)layer * DM * DM;
        const float* norm_x_g = args.in[9] + (size_t)layer * DM;
        const float* norm_mem_g = args.in[10] + (size_t)layer * DM;
        const float* w_xq = args.in[11] + (size_t)layer * DM * DM;
        const float* w_xkv = args.in[12] + (size_t)layer * DM * 2 * DM;
        const float* w_xo = args.in[13] + (size_t)layer * DM * DM;
        const float* norm_mlp_g = args.in[14] + (size_t)layer * DM;
        const float* w_up = args.in[15] + (size_t)layer * DM * DFF;
        const float* w_down = args.in[16] + (size_t)layer * DFF * DM;

        REPS(0) if (IN(pb + 0)) { PH_IDS
            LAS float* scr = (LAS float*)(lds + RING_OFF + wave * 16384);
            constexpr int I_IN = (DM / 64) * (INWP / 32), I_SQ = (DM / 64) * (DM / 32), I_KV = (DM / 64) * (2 * DM / 32), I_UP = (DM / 64) * (DFF / 32), I_DN = (DFF / 64) * (DM / 32);
            constexpr int NITEMS = I_IN + 3 * I_SQ + I_KV + I_UP + I_DN;
#define TR_DECODE(P, it_) int P##r = (it_); const float* P##W; bf16* P##T; const float* P##g; int P##K, P##N, P##nb, P##lo = 0, P##hi = 0, P##h2 = 0; \
                if (P##r < I_IN) { P##W = w_in; P##T = Win_t; P##g = norm_mix_g; P##K = DM; P##N = INW; P##nb = INWP / 32; P##lo = PB_Q; P##hi = PB_K; P##h2 = PA_K; } \
                else if ((P##r -= I_IN) < I_SQ) { P##W = w_out; P##T = Wout_t; P##g = nullptr; P##K = DM; P##N = DM; P##nb = DM / 32; } \
                else if ((P##r -= I_SQ) < I_SQ) { P##W = w_xq; P##T = Wxq_t; P##g = norm_x_g; P##K = DM; P##N = DM; P##nb = DM / 32; } \
                else if ((P##r -= I_SQ) < I_KV) { P##W = w_xkv; P##T = Wxkv_t; P##g = norm_mem_g; P##K = DM; P##N = 2 * DM; P##nb = 2 * DM / 32; } \
                else if ((P##r -= I_KV) < I_SQ) { P##W = w_xo; P##T = Wxo_t; P##g = nullptr; P##K = DM; P##N = DM; P##nb = DM / 32; } \
                else if ((P##r -= I_SQ) < I_UP) { P##W = w_up; P##T = Wup_t; P##g = norm_mlp_g; P##K = DM; P##N = DFF; P##nb = DFF / 32; } \
                else { P##r -= I_UP; P##W = w_down; P##T = Wdown_t; P##g = nullptr; P##K = DFF; P##N = DM; P##nb = DM / 32; }
            for (int it = gw; it < NITEMS; it += 6 * NGW) {
                float va[32], vb[32], vc[32], vd[32], ve[32], vf[32];
                TR_DECODE(a_, (it + 0 * NGW < NITEMS) ? it + 0 * NGW : it) TR_DECODE(b_, (it + 1 * NGW < NITEMS) ? it + 1 * NGW : it) TR_DECODE(c_, (it + 2 * NGW < NITEMS) ? it + 2 * NGW : it) TR_DECODE(d_, (it + 3 * NGW < NITEMS) ? it + 3 * NGW : it) TR_DECODE(e_, (it + 4 * NGW < NITEMS) ? it + 4 * NGW : it) TR_DECODE(f_, (it + 5 * NGW < NITEMS) ? it + 5 * NGW : it)
                tr_load(va, a_W, a_N, a_nb, a_r, lane);
                tr_load(vb, b_W, b_N, b_nb, b_r, lane);
                tr_load(vc, c_W, c_N, c_nb, c_r, lane);
                tr_load(vd, d_W, d_N, d_nb, d_r, lane);
                tr_load(ve, e_W, e_N, e_nb, e_r, lane);
                tr_load(vf, f_W, f_N, f_nb, f_r, lane);
                if (it + 0 * NGW < NITEMS) tr_store(va, a_T, a_g, a_K, a_nb, a_r, scr, lane, a_lo, a_hi, 0.125f * LOG2E, a_h2, 0.08838834764831845f * LOG2E);
                if (it + 1 * NGW < NITEMS) tr_store(vb, b_T, b_g, b_K, b_nb, b_r, scr, lane, b_lo, b_hi, 0.125f * LOG2E, b_h2, 0.08838834764831845f * LOG2E);
                if (it + 2 * NGW < NITEMS) tr_store(vc, c_T, c_g, c_K, c_nb, c_r, scr, lane, c_lo, c_hi, 0.125f * LOG2E, c_h2, 0.08838834764831845f * LOG2E);
                if (it + 3 * NGW < NITEMS) tr_store(vd, d_T, d_g, d_K, d_nb, d_r, scr, lane, d_lo, d_hi, 0.125f * LOG2E, d_h2, 0.08838834764831845f * LOG2E);
                if (it + 4 * NGW < NITEMS) tr_store(ve, e_T, e_g, e_K, e_nb, e_r, scr, lane, e_lo, e_hi, 0.125f * LOG2E, e_h2, 0.08838834764831845f * LOG2E);
                if (it + 5 * NGW < NITEMS) tr_store(vf, f_T, f_g, f_K, f_nb, f_r, scr, lane, f_lo, f_hi, 0.125f * LOG2E, f_h2, 0.08838834764831845f * LOG2E);
            }
#undef TR_DECODE
            rownorm_bf16(mem, MEMB, NBATCH * MEML, gw, NGW, lane);
            if (layer == 0) rownorm_bf16(x, ACT0, M, gw, NGW, lane);
            __syncthreads();
        }
        SEAM(pb + 0);
        REPS(2) if (IN(pb + 2)) {
            pg8::Gemm g{layer == 0 ? ACT0 : XRES, Win_t, M, INWP, DM}; pg8::StaticOrder S; S.init(M, INWP, G, bx);
            if (layer != 0) BUILD_RTAB(S);
            pg8::EpiBf16<0, true> E{PROJ, INWP, 1.f, GATES, PC_G, layer == 0 ? (const LAS float*)nullptr : (const LAS float*)(lds + 132096)};
            pg8::gemm_phase<pg8::EpiBf16<0, true>, pg8::StaticOrder, PG8_ALIGN, PG8_SP2>(lds + RING_OFF, g, S, E);
        }
        SEAM(pb + 2);
        REPS(3) if (IN(pb + 3)) { PH_IDS
#if (MK_SKIP & 7)
            for (size_t i = gt; i < (size_t)M * DM / 8; i += NTH) ((v4u*)ACT0)[i] = (v4u){0u, 0u, 0u, 0u};
#endif
            for (size_t it0 = gt; it0 < (size_t)M * 192; it0 += 4 * NTH) {
                bf16x8 u0[4], u1[4], u2[4]; size_t mm[4]; int cc[4]; bool ok[4];
#pragma unroll
                for (int k = 0; k < 4; ++k) { const size_t it = it0 + k * NTH; ok[k] = it < (size_t)M * 192; const size_t itc = ok[k] ? it : it0;
                    const size_t m = itc / 192; const int c8 = (int)(itc % 192) * 8; const int t = (int)(m % T); mm[k] = m; cc[k] = c8;
                    const bf16* up = PROJ + m * INWP + PC_QK + c8;
                    u1[k] = *(const bf16x8*)up; u0[k] = (bf16x8){0, 0, 0, 0, 0, 0, 0, 0}; u2[k] = (bf16x8){0, 0, 0, 0, 0, 0, 0, 0};
                    if (t > 0) u0[k] = *(const bf16x8*)(up - INWP);
                    if (t < T - 1) u2[k] = *(const bf16x8*)(up + INWP); }
                asm volatile("" ::: "memory");
#pragma unroll
                for (int k = 0; k < 4; ++k) { const int c8 = cc[k]; float y[8];
#pragma unroll
                    for (int e = 0; e < 8; ++e) { const float xx = conv_w[c8 + e] * bf2f((unsigned short)u0[k][e]) + conv_w[1536 + c8 + e] * bf2f((unsigned short)u1[k][e]) + conv_w[3072 + c8 + e] * bf2f((unsigned short)u2[k][e]);
                        float s = xx * __builtin_amdgcn_rcpf(1.f + ex2(-xx * LOG2E)); if (c8 < 768) s *= 0.08838834764831845f; y[e] = s; }
                    if (ok[k]) *(bf16x8*)(CQK + mm[k] * 1536 + c8) = pack8(y); }
            }
            {   LAS unsigned* NM = (LAS unsigned*)(lds + RING_OFF);
                if (tid < 64) NM[tid] = 0u;
                __syncthreads();
                for (size_t it0 = gt; it0 < (size_t)M * 128; it0 += 4 * NTH) { bf16x8 uu[4]; bool ok[4];
#pragma unroll
                    for (int k = 0; k < 4; ++k) { const size_t it = it0 + k * NTH; ok[k] = it < (size_t)M * 128; const size_t itc = ok[k] ? it : it0; uu[k] = *(const bf16x8*)(PROJ + (itc >> 7) * INWP + PB_Q + (int)(itc & 127) * 8); }
#pragma unroll
                    for (int k = 0; k < 4; ++k) { const size_t it = it0 + k * NTH; const size_t m = it >> 7; const int rem = (int)(it & 127); float s = 0.f;
#pragma unroll
                        for (int e = 0; e < 8; ++e) { const float v = bf2f((unsigned short)uu[k][e]); s = fmaf(v, v, s); }
                        s += __shfl_xor(s, 1); s += __shfl_xor(s, 2); s += __shfl_xor(s, 4);
                        if (ok[k] && (lane & 7) == 0) atomicMax((unsigned*)(NM + (int)(m / T) * 16 + (rem >> 3)), __float_as_uint(s)); } }
                __syncthreads();
                if (tid < 64) NRM[(size_t)bx * 64 + tid] = __uint_as_float(NM[tid]);
            }
            for (int task = gw; task < 48 * NCH; task += NGW) {
                const int seq = task / NCH, c = task % NCH, dir = seq / 24, bh = seq % 24, b = bh / CH, h = bh % CH;
                const float bi = gate_b[(dir ? 2 : 0) * CH + h], bf_ = gate_b[(dir ? 3 : 1) * CH + h];
                const int i0 = 2 * lane, i1 = 2 * lane + 1;
                const int t0 = c * LC + (dir ? LC - 1 - i0 : i0), t1 = c * LC + (dir ? LC - 1 - i1 : i1);
                const float* g0 = GATES + ((size_t)b * T + t0) * 24; const float* g1 = GATES + ((size_t)b * T + t1) * 24;
                const float li0 = g0[(dir ? 2 : 0) * CH + h] + bi, li1 = g1[(dir ? 2 : 0) * CH + h] + bi;
                const float lf0 = log_sigmoid(g0[(dir ? 3 : 1) * CH + h] + bf_), lf1 = log_sigmoid(g1[(dir ? 3 : 1) * CH + h] + bf_);
                const float incl = wave_incl_sum(lf0 + lf1, lane);
                const float bc1 = incl, bc0 = incl - lf1;
                const float a0 = li0 - bc0, a1 = li1 - bc1;
                const float imx = wave_incl_max(fmaxf(a0, a1), lane);
                float emx = __shfl_up(imx, 1); if (lane == 0) emx = -INFINITY;
                const size_t sq = (size_t)seq * T;
                GA[sq + t0] = a0; GA[sq + t1] = a1; GM[sq + t0] = fmaxf(emx, a0); GM[sq + t1] = imx; GB[sq + t0] = bc0; GB[sq + t1] = bc1;
                if (lane == 63) { BLa[seq * NCH + c] = bc1; ALa[seq * NCH + c] = imx; }
            }
        }
        SEAM(pb + 3);
        REPS(4) if (IN(pb + 4)) {
            LAS float* TMS = (LAS float*)(lds + TBL_OFF); LAS float* TML = TMS + 48 * NCH;
            {   PH_IDS
                if (tid < 48) { const int seq = tid, dir = seq / 24; float ms = 0.f;
                    for (int p = 0; p < NCH; ++p) { const int c = dir ? NCH - 1 - p : p; const float ml = fmaxf(ms, ALa[seq * NCH + c]);
                        TMS[seq * NCH + c] = ms; TML[seq * NCH + c] = ml; if (bx == 0) { MSa[seq * NCH + c] = ms; MLa[seq * NCH + c] = ml; }
                        ms = BLa[seq * NCH + c] + ml; } }
                __syncthreads(); }
#if !(MK_SKIP & 1)
            REPS(40) for (int u = bx; u < 1152; u += G) { const int xc = u & 7, w = u >> 3, bh = xc + 8 * (w / 48), rem = w % 48, cfg = rem / 16, i16 = rem % 16;
                const int rho = cfg == 0 ? 0 : (cfg == 1 ? (i16 >> 2) : i16), seg = cfg == 0 ? i16 : (cfg == 1 ? (i16 & 3) : 0);
                dilattn_unit((LAS char*)lds, PROJ, OG, LSE, bh / AH, bh % AH, cfg, rho, seg, (MK_REP_PHASE == 40 && rep_ < MK_REP_N) ? MK_A_MODE : 0); }
#endif
#if MK_TIME_A >= 0
            if (bx == MK_TIME_BLK && threadIdx.x == 0) TS[34 + layer] = __builtin_amdgcn_s_memrealtime();
#endif
#if !(MK_SKIP & 4)
            REPS(41) for (int u = bx; u < 768; u += G) { const int xc = u & 7, w = u >> 3, bh = xc + 8 * (w / 32), c = w % 32;
                mlstm_dc_unit((LAS char*)lds, CQK, PROJ, GA, TML, DC, DN, bh / CH, bh % CH, c); }
#endif
        }
        SEAM(pb + 4);
        REPS(5) if (IN(pb + 5)) { PH_IDS
            const bool split_ = G > 128, kvblk = split_ && bx < 64;
            if (kvblk || !split_) {
                pg8::Gemm g{MEMB, Wxkv_t, NBATCH * MEML, 2 * DM, DM}; pg8::StaticOrder S; S.init(NBATCH * MEML, 2 * DM, G, bx);
                pg8::EpiBf16<0, false> E{KV, 2 * DM, 1.f, nullptr, 0, (const LAS float*)nullptr};
                pg8::gemm_phase<pg8::EpiBf16<0, false>, pg8::StaticOrder, PG8_ALIGN, PG8_SP2>(lds + RING_OFF, g, S, E);
            }
            if (!kvblk) {
            const size_t gtT = split_ ? (size_t)(bx - 64) * (NWAVES * 64) + tid : gt, NTHT = split_ ? (size_t)(G - 64) * NWAVES * 64 : NTH;
#if !(MK_SKIP & 4)
            for (size_t g2 = gtT; g2 < (size_t)48 * 2048; g2 += NTHT) { const int sq = (int)(g2 / 2048), e8 = (int)(g2 % 2048) * 8, dir = sq / 24;
                float S[8];
#pragma unroll
                for (int e = 0; e < 8; ++e) S[e] = 0.f;
                for (int p0 = 0; p0 < NCH; p0 += 8) {
                    bf16x8 xv[8]; float dec[8];
#pragma unroll
                    for (int q = 0; q < 8; ++q) { const int c = dir ? NCH - 1 - (p0 + q) : p0 + q;
                        xv[q] = *(const bf16x8*)(DC + ((size_t)sq * NCH + c) * (LC * HD) + e8); dec[q] = MSa[sq * NCH + c] - MLa[sq * NCH + c]; }
                    asm volatile("" ::: "memory");
#pragma unroll
                    for (int q = 0; q < 8; ++q) { const int c = dir ? NCH - 1 - (p0 + q) : p0 + q; const float dc = expf(dec[q]);
                        *(bf16x8*)(DC + ((size_t)sq * NCH + c) * (LC * HD) + e8) = pack8(S);
#pragma unroll
                        for (int e = 0; e < 8; ++e) S[e] = fmaf(dc, S[e], bf2f((unsigned short)xv[q][e])); }
                }
            }
            for (size_t g2 = gtT; g2 < (size_t)48 * 128; g2 += NTHT) { const int sq = (int)(g2 / 128), d = (int)(g2 % 128), dir = sq / 24; float S = 0.f;
                for (int p0 = 0; p0 < NCH; p0 += 8) { float xv[8], dec[8];
#pragma unroll
                    for (int q = 0; q < 8; ++q) { const int c = dir ? NCH - 1 - (p0 + q) : p0 + q; xv[q] = DN[((size_t)sq * NCH + c) * HD + d]; dec[q] = MSa[sq * NCH + c] - MLa[sq * NCH + c]; }
                    asm volatile("" ::: "memory");
#pragma unroll
                    for (int q = 0; q < 8; ++q) { const int c = dir ? NCH - 1 - (p0 + q) : p0 + q; DN[((size_t)sq * NCH + c) * HD + d] = S; S = fmaf(expf(dec[q]), S, xv[q]); }
                }
            }
#endif
#if !(MK_SKIP & 1)
            for (size_t it0 = gtT; it0 < (size_t)M * AH * 16; it0 += 4 * NTHT) {
                float lv[4][3]; bf16x8 ov[4][3]; size_t mm[4]; int hh[4], cc[4]; bool ok[4];
#pragma unroll
                for (int k = 0; k < 4; ++k) { const size_t it = it0 + k * NTHT; ok[k] = it < (size_t)M * AH * 16; const size_t itc = ok[k] ? it : it0;
                    const size_t m = itc / (AH * 16); const int rem = (int)(itc % (AH * 16)), h = rem >> 4, c8 = (rem & 15) * 8; mm[k] = m; hh[k] = h; cc[k] = c8;
#pragma unroll
                    for (int g = 0; g < 3; ++g) { lv[k][g] = LSE[(g * (size_t)M + m) * AH + h]; ov[k][g] = *(const bf16x8*)(OG + (g * (size_t)M + m) * 768 + h * 128 + c8); } }
                asm volatile("" ::: "memory");
#pragma unroll
                for (int k = 0; k < 4; ++k) { const int h = hh[k], c8 = cc[k];
                    const float mx = fmaxf(lv[k][0], fmaxf(lv[k][1], lv[k][2])); float w0 = expf(lv[k][0] - mx), w1 = expf(lv[k][1] - mx), w2 = expf(lv[k][2] - mx); const float inv = 1.f / (w0 + w1 + w2); w0 *= inv; w1 *= inv; w2 *= inv;
                    float y[8]; float ss = 0.f;
#pragma unroll
                    for (int e = 0; e < 8; ++e) { y[e] = w0 * bf2f((unsigned short)ov[k][0][e]) + w1 * bf2f((unsigned short)ov[k][1][e]) + w2 * bf2f((unsigned short)ov[k][2][e]); ss = fmaf(y[e], y[e], ss); }
                    ss += __shfl_xor(ss, 1); ss += __shfl_xor(ss, 2); ss += __shfl_xor(ss, 4); ss += __shfl_xor(ss, 8);
                    const float rs = __builtin_amdgcn_rsqf(ss * (1.f / 128.f) + EPS);
#pragma unroll
                    for (int e = 0; e < 8; ++e) y[e] *= rs * head_norm_g[h * 128 + c8 + e];
                    if (ok[k]) *(bf16x8*)(ACT0 + mm[k] * DM + h * 128 + c8) = pack8(y); }
            }
#endif
            }
        }
        SEAM(pb + 5);
        REPS(6) if (IN(pb + 6)) { PH_IDS
#if !(MK_SKIP & 2)
            {
                LAS int* qslot = (LAS int*)(lds + 140000);
                gu32* qctr = ctl + 8192 + 64 * layer;
                if (wave == 0) { const float* dl = diff_lambda;
                    const float s1 = wave_sum(dl[lane] * dl[64 + lane]), s2 = wave_sum(dl[128 + lane] * dl[192 + lane]);
                    const float lam_init = 0.8f - 0.6f * expf(-0.3f * (float)layer);
                    if (lane == 0) { ((LAS float*)qslot)[1] = expf(s1) - expf(s2) + lam_init; ((LAS float*)qslot)[2] = 1.f - lam_init; } }
                for (;;) {
                    __syncthreads();
                    if (threadIdx.x == 0) qslot[0] = (int)__hip_atomic_fetch_add(qctr, 1u, RLX_AGENT);
                    __syncthreads();
                    const int cur = __builtin_amdgcn_readfirstlane(qslot[0]);
                    if (cur >= 512 + 256) break;
                    if (cur < 512) { const int h = 3 - (cur >> 7), r = cur & 127, qbi = r >> 2, qb = (qbi & 1) ? 15 - (qbi >> 1) : 16 + (qbi >> 1);
                        diffattn_unit((LAS char*)lds, PROJ, ACT0, head_norm_g, ((LAS float*)qslot)[1], ((LAS float*)qslot)[2], NRM, G, r & 3, h, qb); }
                    else { for (int k = 0; k < 3; ++k) { const int u = (cur - 512) * 3 + k, xc = u & 7, w = u >> 3, bh = xc + 8 * (w / 32), c = w % 32;
                            mlstm_out_unit((LAS char*)lds, CQK, PROJ, GA, GM, GB, MSa, DC, DN, ACT0, head_norm_g, bh / CH, bh % CH, c); } }
                }
            }
#endif
        }
        SEAM(pb + 6);
        REPS(7) if (IN(pb + 7)) {
            pg8::Gemm g{ACT0, Wout_t, M, DM, DM}; pg8::StaticOrder S; S.init(M, DM, G, bx);
            if (layer == 0) { pg8::EpiResBf16<true> E{x, (MK_REP_PHASE == 7 && rep_ < MK_REP_N) ? ACT1 : XRES, SSP}; pg8::gemm_phase<pg8::EpiResBf16<true>, pg8::StaticOrder, PG8_ALIGN, PG8_SP2>(lds + RING_OFF, g, S, E); }
            else { pg8::EpiResBf16<false> E{XRES, (MK_REP_PHASE == 7 && rep_ < MK_REP_N) ? ACT1 : XRES, SSP}; pg8::gemm_phase<pg8::EpiResBf16<false>, pg8::StaticOrder, PG8_ALIGN, PG8_SP2>(lds + RING_OFF, g, S, E); }
        }
        SEAM(pb + 7);
        REPS(9) if (IN(pb + 9)) {
            pg8::Gemm g{XRES, Wxq_t, M, DM, DM}; pg8::StaticOrder S; S.init(M, DM, G, bx);
                        BUILD_RTAB(S);
            pg8::EpiBf16<0, false> E{ACT0, DM, 0.044194173824159216f * LOG2E, nullptr, 0, (const LAS float*)(lds + 132096)};
            pg8::gemm_phase<pg8::EpiBf16<0, false>, pg8::StaticOrder, PG8_ALIGN, PG8_SP2>(lds + RING_OFF, g, S, E);
        }
        SEAM(pb + 9);
        REPS(10) if (IN(pb + 10)) {
            for (int u = bx; u < 256; u += G) { const int xc = u & 7, w = u >> 3, bh = xc + 8 * (w / 16), qb = w % 16;
                xattn_unit((LAS char*)lds, ACT0, KV, ACT1, bh / XH, bh % XH, qb); }
        }
        SEAM(pb + 10);
        REPS(11) if (IN(pb + 11)) {
            pg8::Gemm g{ACT1, Wxo_t, M, DM, DM}; pg8::StaticOrder S; S.init(M, DM, G, bx);
            pg8::EpiResBf16<false> E{XRES, (MK_REP_PHASE == 11 && rep_ < MK_REP_N) ? ACT0 : XRES, SSP};
            pg8::gemm_phase<pg8::EpiResBf16<false>, pg8::StaticOrder, PG8_ALIGN, PG8_SP2>(lds + RING_OFF, g, S, E);
        }
        SEAM(pb + 11);
        for (int hf = 0; hf < 2; ++hf) {
            const size_t ro = (size_t)hf * (M / 2);
            if (IN(pb + 13)) {
                pg8::Gemm g{XRES + ro * DM, Wup_t, M / 2, DFF, DM}; pg8::StaticOrder S; S.init(M / 2, DFF, G, bx);
                build_rtab(S, SSP + ro * 32, (LAS float*)(lds + 132096));
                pg8::EpiBf16<1, false> E{HID + (MK_PER_PHASE ? ro * DFF : 0), DFF, 1.f, nullptr, 0, (const LAS float*)(lds + 132096), 0};
                pg8::gemm_phase<pg8::EpiBf16<1, false>, pg8::StaticOrder, PG8_ALIGN, PG8_SP2>(lds + RING_OFF, g, S, E);
            }
            if (IN(pb + 13) && IN(pb + 14)) xcd_barrier(bar);
            if (IN(pb + 14)) {
                pg8::Gemm g{HID + (MK_PER_PHASE ? ro * DFF : 0), Wdown_t, M / 2, DM, DFF}; pg8::StaticOrder S; S.init(M / 2, DM, G, bx);
                pg8::EpiResBf16<false> E{XRES + ro * DM, XRES + ro * DM, SSP + ro * 32};
                pg8::gemm_phase<pg8::EpiResBf16<false>, pg8::StaticOrder, PG8_ALIGN, PG8_SP2>(lds + RING_OFF, g, S, E);
            }
            if (hf == 0 && IN(pb + 13) && IN(pb + 14)) xcd_barrier(bar);
        }
        SEAM(pb + 14);
    }
    if (IN(DEPTH * NPH)) { PH_IDS
        const float* fg = args.in[17];
#if MK_TIME_A >= 0 || MK_TIME_B >= 0
        xcd_barrier(bar);
#define TPREV(k) ((k) == 9 ? 7 : ((k) == 14 ? 11 : ((k) == 2 ? 0 : (k) - 1)))
#define TDUR(k) ((float)((TS[k] - ((k) == 0 ? TS[63] : TS[TPREV(k)])) + (TS[NPH + (k)] - TS[NPH + TPREV(k)])) * 0.01f)
#endif
#if MK_TIME_A >= 0
#if MK_TIME_A == 110
        const float tscale_ = 1.f + (float)((TS[34] - TS[3]) + (TS[35] - TS[NPH + 3])) * 0.01f * (1.f / MK_TIME_DIV);
#elif MK_TIME_A == 200
        const float tscale_ = 1.f + (float)(TS[2 * NPH - 1] - TS[63]) * 0.01f * (1.f / MK_TIME_DIV);
#elif MK_TIME_A >= 101
        const float tscale_ = 1.f + (float)(TS[40 + MK_TIME_A - 100] - (MK_TIME_A == 101 ? TS[32] : TS[40 + MK_TIME_A - 101])) * 0.01f * (1.f / MK_TIME_DIV);
#elif MK_TIME_A == 100
        const float tscale_ = 1.f + (float)((TS[32] - TS[5]) + (TS[33] - TS[NPH + 5])) * 0.01f * (1.f / MK_TIME_DIV);
#else
        const float tscale_ = 1.f + TDUR(MK_TIME_A) * (1.f / MK_TIME_DIV);
#endif
#endif
#if MK_TIME_B >= 0
        const float tspike_ = TDUR(MK_TIME_B) * 0.1f;
#endif
        for (int m0 = gw; m0 < M; m0 += 2 * NGW) {
            const int m1 = m0 + NGW < M ? m0 + NGW : m0;
            unsigned long long wa[8], wb[8]; f32x4 g4[8];
            const unsigned long long* ha = (const unsigned long long*)(XRES + (size_t)m0 * DM) + lane; const unsigned long long* hb = (const unsigned long long*)(XRES + (size_t)m1 * DM) + lane;
            const float pa = lane < 32 ? SSP[(size_t)m0 * 32 + lane] : 0.f, pb = lane < 32 ? SSP[(size_t)m1 * 32 + lane] : 0.f;
#pragma unroll
            for (int j = 0; j < 8; ++j) { wa[j] = ha[64 * j]; wb[j] = hb[64 * j]; g4[j] = ((const f32x4*)fg + lane)[64 * j]; }
            const float rsa = 1.0f / sqrtf(wave_sum(pa) * (1.f / DM) + EPS), rsb = 1.0f / sqrtf(wave_sum(pb) * (1.f / DM) + EPS);
#pragma unroll
            for (int k = 0; k < 2; ++k) { if (k == 1 && m1 == m0) break; const int m = k ? m1 : m0; const float rs = k ? rsb : rsa; f32x4* xr = (f32x4*)(out + (size_t)m * DM) + lane;
#pragma unroll
                for (int j = 0; j < 8; ++j) { const unsigned long long w = k ? wb[j] : wa[j]; const unsigned lo = (unsigned)w, hi2 = (unsigned)(w >> 32);
                    const f32x4 v = {__uint_as_float(lo << 16), __uint_as_float(lo & 0xffff0000u), __uint_as_float(hi2 << 16), __uint_as_float(hi2 & 0xffff0000u)};
#if MK_TIME_A >= 0
                    xr[64 * j] = v * rs * g4[j] * tscale_;
#else
                    xr[64 * j] = v * rs * g4[j];
#endif
                }
#if MK_TIME_B >= 0
                if (m == 0 && lane == 0) out[0] += tspike_;
#endif
            }
        }
    }
#undef IN
#undef SEAM
}

extern "C" void kernel_launch(void* const* d_in, const int* in_sizes, int n_in, void* d_out, int out_size, void* d_ws, size_t ws_size, hipStream_t stream) {
    static int grid = 0;
    if (grid == 0) {
        if (n_in != 18 || in_sizes[0] != M * DM || out_size != M * DM || ws_size < WS_END) {
            fprintf(stderr, "kernel_launch: shape / workspace mismatch (n_in %d, in0 %d, out %d, ws %zu, need %zu); nothing launched\n", n_in, n_in > 0 ? in_sizes[0] : -1, out_size, ws_size, (size_t)WS_END); grid = -1; return; }
        int dev = 0, cus = 0, per_cu = 0;
        if (hipGetDevice(&dev) != hipSuccess || hipDeviceGetAttribute(&cus, hipDeviceAttributeMultiprocessorCount, dev) != hipSuccess) { grid = -1; return; }
        if (hipFuncSetAttribute((const void*)enc_fwd, hipFuncAttributeMaxDynamicSharedMemorySize, LDS_BYTES) != hipSuccess) { fprintf(stderr, "kernel_launch: hipFuncSetAttribute failed\n"); grid = -1; return; }
        if (hipOccupancyMaxActiveBlocksPerMultiprocessor(&per_cu, (const void*)enc_fwd, NWAVES * 64, LDS_BYTES) != hipSuccess || per_cu < 1) { fprintf(stderr, "kernel_launch: occupancy query says %d blocks per CU\n", per_cu); }
        (void)hipGetLastError();
        grid = cus;
    }
    if (grid < 0) return;
    if (hipMemsetAsync((char*)d_ws + WS_CTL, 0, CTL_ZERO_BYTES, stream) != hipSuccess) return;
    Args a{};
    for (int i = 0; i < 18; ++i) a.in[i] = (const float*)d_in[i];
    a.out = (float*)d_out; a.ws = (unsigned char*)d_ws;
#if MK_PER_PHASE
    for (int p = 0; p < NPHT; ++p) { a.ph_lo = p; a.ph_hi = p + 1; hipLaunchKernelGGL(enc_fwd, dim3(grid), dim3(NWAVES * 64), LDS_BYTES, stream, a); }
#else
    a.ph_lo = 0; a.ph_hi = NPHT;
    hipLaunchKernelGGL(enc_fwd, dim3(grid), dim3(NWAVES * 64), LDS_BYTES, stream, a);
#endif
    const hipError_t le = hipPeekAtLastError();
    if (le != hipSuccess) fprintf(stderr, "kernel_launch: launch failed: %s\n", hipGetErrorName(le));
}
```

```cpp
#include <hip/hip_runtime.h>
#include <cstdio>
#include <cstdint>
#include <cmath>

#ifndef MK_PER_PHASE
#define MK_PER_PHASE 0
#endif
#ifndef MK_SKIP
#define MK_SKIP 0
#endif

#ifndef MK_REP_PHASE
#define MK_REP_PHASE -1
#endif
#ifndef MK_REP_N
#define MK_REP_N 1
#endif

#ifndef MK_TIME_A
#define MK_TIME_A -1
#endif
#ifndef MK_TIME_BLK
#define MK_TIME_BLK 0
#endif
#ifndef MK_TIME_DIV
#define MK_TIME_DIV 50000.f
#endif
#ifndef MK_TIME_B
#define MK_TIME_B -1
#endif

#ifndef MK_SKEW_TICKS
#define MK_SKEW_TICKS 0
#endif

#ifndef MK_P9_MODE
#define MK_P9_MODE 0
#endif

#ifndef MK_A_MODE
#define MK_A_MODE 0
#endif

#ifndef MK_B_MODE
#define MK_B_MODE 0
#endif

namespace pg8 {
#define PG8_LAS __attribute__((address_space(3)))
typedef unsigned short bf16_t;
typedef short bf16x8 __attribute__((ext_vector_type(8)));
typedef float f32x4 __attribute__((ext_vector_type(4)));
typedef unsigned u32x4 __attribute__((ext_vector_type(4)));
constexpr int BM = 256, BK = 64, HALF = 128, HTB = HALF * BK * 2  , STAGE_BYTES = 8 * HTB, NXCD = 8, WGM = 8;

__host__ __device__ __forceinline__ int lds_byte(int r, int c) { const int st = (r >> 4) * 2 + (c >> 5), rr = r & 15, cc = c & 31, ob = rr * 64 + cc * 2; return st * 1024 + (ob ^ (((ob >> 9) & 1) << 5)); }
__host__ __device__ __forceinline__ void stage_rc(int b, int& R, int& C) { const int st = b / 1024, sb = b % 1024, swz = sb ^ (((sb >> 9) & 1) << 5); R = (st >> 1) * 16 + swz / 64; C = (st & 1) * 32 + (swz % 64) / 2; }
__host__ __device__ __forceinline__ int perm32(int rho) { const int n = rho >> 4, i = rho & 15; return 8 * (i >> 2) + 4 * n + (i & 3); }

struct Unit { int pm, pn; };
struct Gemm { const bf16_t* A; const bf16_t* Bt; int M, N, K; };

struct StaticOrder {
    int nM, nN, nwg, G, c;
    __host__ __device__ void init(int M, int N, int G_, int c_) { nM = M / BM; nN = N / BM; nwg = nM * nN; G = G_; c = c_; }
    __host__ __device__ bool next(int i, Unit& u) const {
        const long L = (long)i * G + c; if (L >= nwg) return false;
        int wgid = (int)L; { const int q = nwg / NXCD, r = nwg % NXCD, xcd = wgid % NXCD, off = wgid / NXCD; wgid = (xcd < r ? xcd * (q + 1) : r * (q + 1) + (xcd - r) * q) + off; }
        const int nig = WGM * nN, gid = wgid / nig, fm = gid * WGM, gsz = (nM - fm) < WGM ? (nM - fm) : WGM;
        u.pm = fm + ((wgid % nig) % gsz); u.pn = (wgid % nig) / gsz; return true;
    }
    __device__ __forceinline__ void a_ready(const Unit&) const {}
    __device__ __forceinline__ void done(const Unit&) const {}
};

__device__ __forceinline__ unsigned cvt_pk_bf16(float lo, float hi) { unsigned r; asm volatile("v_cvt_pk_bf16_f32 %0, %1, %2" : "=v"(r) : "v"(lo), "v"(hi)); return r; }
typedef float f32x2 __attribute__((ext_vector_type(2)));

template <int ACT, bool SIDE, int TILED = 0> struct EpiBf16 {
    static constexpr bool PERM = true, AFTER_DRAIN = false;
    bf16_t* O; int ldc; float scale; float* side; int side_c0; const PG8_LAS float* rtab; int dry = 0;
    __device__ __forceinline__ void operator()(const f32x4 (&acc)[2][2][4][2], const Unit& u, int wr, int wc, int fr, int fq, int ui) const {
        const int row0 = u.pm * BM + wr * 64 + fr; const int col0 = u.pn * BM + wc * 32 + 8 * fq;
        if (dry) { float s = 0.f;
#pragma unroll
            for (int ai = 0; ai < 2; ++ai)
#pragma unroll
                for (int bj = 0; bj < 2; ++bj)
#pragma unroll
                    for (int m = 0; m < 4; ++m)
#pragma unroll
                        for (int n = 0; n < 2; ++n) s += acc[ai][bj][m][n][0] + acc[ai][bj][m][n][1] + acc[ai][bj][m][n][2] + acc[ai][bj][m][n][3];
            if (s == 1.2345e30f) O[0] = 0; return; }
        float fac[2][4];
#pragma unroll
        for (int ai = 0; ai < 2; ++ai)
#pragma unroll
            for (int m = 0; m < 4; ++m) fac[ai][m] = rtab ? scale * rtab[ui * 256 + wr * 64 + fr + ai * HALF + m * 16] : scale;
#pragma unroll
        for (int ai = 0; ai < 2; ++ai)
#pragma unroll
            for (int m = 0; m < 4; ++m) { const int row = row0 + ai * HALF + m * 16; bf16_t* rowp = TILED ? O + ((size_t)(u.pm * TILED + u.pn) << 16) + (wr * 64 + fr + ai * HALF + m * 16) * 256 + wc * 32 + 8 * fq : O + (size_t)row * ldc + col0;
                const float f = fac[ai][m];
                if (SIDE) { const int sc = col0 - side_c0;
                    if (sc >= 0 && sc < 24) { float* sp = side + (size_t)row * 24 + sc; *(f32x4*)sp = acc[ai][0][m][0] * f; *(f32x4*)(sp + 4) = acc[ai][0][m][1] * f; } }
#pragma unroll
                for (int bj = 0; bj < 2; ++bj) { f32x4 v0 = acc[ai][bj][m][0] * f, v1 = acc[ai][bj][m][1] * f;
                    if (ACT == 1) {
#pragma unroll
                        for (int e = 0; e < 4; ++e) { const float a = fmaxf(v0[e], 0.f), b = fmaxf(v1[e], 0.f); v0[e] = a * a; v1[e] = b * b; } }
                    u32x4 w; w.x = cvt_pk_bf16(v0[0], v0[1]); w.y = cvt_pk_bf16(v0[2], v0[3]); w.z = cvt_pk_bf16(v1[0], v1[1]); w.w = cvt_pk_bf16(v1[2], v1[3]);
                    *(u32x4*)(rowp + bj * HALF) = w; } }
    }
};
template <bool BASE_F32> struct EpiResBf16 {
    static constexpr bool PERM = true, AFTER_DRAIN = false;
    const void* base; bf16_t* hb; float* ss;
    __device__ __forceinline__ void operator()(const f32x4 (&acc)[2][2][4][2], const Unit& u, int wr, int wc, int fr, int fq, int ui) const {
        const int row0 = u.pm * BM + wr * 64 + fr, col0 = u.pn * BM + wc * 32 + 8 * fq;
        if constexpr (!BASE_F32) {
            u32x4 bw[8][2];
#pragma unroll
            for (int k = 0; k < 6; ++k)
#pragma unroll
                for (int bj = 0; bj < 2; ++bj) bw[k][bj] = *(const u32x4*)((const bf16_t*)base + (size_t)(row0 + (k >> 2) * HALF + (k & 3) * 16) * 2048 + col0 + bj * HALF);
#pragma unroll
            for (int k = 0; k < 8; ++k) { const int ai = k >> 2, m = k & 3; const int row = row0 + ai * HALF + m * 16; const size_t off = (size_t)row * 2048 + col0; float s2 = 0.f;
                asm volatile("" ::: "memory");
                if (k + 6 < 8) {
#pragma unroll
                    for (int bj = 0; bj < 2; ++bj) bw[k + 6][bj] = *(const u32x4*)((const bf16_t*)base + (size_t)(row0 + ((k + 6) >> 2) * HALF + ((k + 6) & 3) * 16) * 2048 + col0 + bj * HALF); }
#pragma unroll
                for (int bj = 0; bj < 2; ++bj) { const size_t o = off + bj * HALF; const u32x4 w = bw[k][bj];
                    const f32x4 b0 = {__uint_as_float(w.x << 16), __uint_as_float(w.x & 0xffff0000u), __uint_as_float(w.y << 16), __uint_as_float(w.y & 0xffff0000u)};
                    const f32x4 b1 = {__uint_as_float(w.z << 16), __uint_as_float(w.z & 0xffff0000u), __uint_as_float(w.w << 16), __uint_as_float(w.w & 0xffff0000u)};
                    const f32x4 v0 = b0 + acc[ai][bj][m][0], v1 = b1 + acc[ai][bj][m][1];
                    s2 += ((v0[0] * v0[0] + v0[1] * v0[1]) + (v0[2] * v0[2] + v0[3] * v0[3])) + ((v1[0] * v1[0] + v1[1] * v1[1]) + (v1[2] * v1[2] + v1[3] * v1[3]));
                    u32x4 w2; w2.x = cvt_pk_bf16(v0[0], v0[1]); w2.y = cvt_pk_bf16(v0[2], v0[3]); w2.z = cvt_pk_bf16(v1[0], v1[1]); w2.w = cvt_pk_bf16(v1[2], v1[3]);
                    *(u32x4*)(hb + o) = w2; }
                s2 += __shfl_xor(s2, 16); s2 += __shfl_xor(s2, 32);
                if (fq == 0) ss[(size_t)row * 32 + u.pn * 4 + wc] = s2; }
        } else {
#pragma unroll
            for (int ai = 0; ai < 2; ++ai) {
                f32x4 b0[4][2], b1[4][2];
#pragma unroll
                for (int m = 0; m < 4; ++m)
#pragma unroll
                    for (int bj = 0; bj < 2; ++bj) { const size_t o = (size_t)(row0 + ai * HALF + m * 16) * 2048 + col0 + bj * HALF;
                        b0[m][bj] = *(const f32x4*)((const float*)base + o); b1[m][bj] = *(const f32x4*)((const float*)base + o + 4); }
                asm volatile("" ::: "memory");
#pragma unroll
                for (int m = 0; m < 4; ++m) { const int row = row0 + ai * HALF + m * 16; const size_t off = (size_t)row * 2048 + col0; float s2 = 0.f;
#pragma unroll
                    for (int bj = 0; bj < 2; ++bj) { const size_t o = off + bj * HALF;
                        const f32x4 v0 = b0[m][bj] + acc[ai][bj][m][0], v1 = b1[m][bj] + acc[ai][bj][m][1];
                        s2 += ((v0[0] * v0[0] + v0[1] * v0[1]) + (v0[2] * v0[2] + v0[3] * v0[3])) + ((v1[0] * v1[0] + v1[1] * v1[1]) + (v1[2] * v1[2] + v1[3] * v1[3]));
                        u32x4 w2; w2.x = cvt_pk_bf16(v0[0], v0[1]); w2.y = cvt_pk_bf16(v0[2], v0[3]); w2.z = cvt_pk_bf16(v1[0], v1[1]); w2.w = cvt_pk_bf16(v1[2], v1[3]);
                        *(u32x4*)(hb + o) = w2; }
                    s2 += __shfl_xor(s2, 16); s2 += __shfl_xor(s2, 32);
                    if (fq == 0) ss[(size_t)row * 32 + u.pn * 4 + wc] = s2; } }
        }
    }
};

template <class Epi, class Sched, bool ALIGN_EPI = false, bool SP2 = false, bool TA = false>
__device__ __forceinline__ void gemm_phase(PG8_LAS unsigned char* lds, const Gemm g, const Sched& S, const Epi& E) {
    int tid_ = threadIdx.x; asm volatile("" : "+v"(tid_)); const int tid = tid_, wid = __builtin_amdgcn_readfirstlane(tid >> 6), lane = tid & 63, wr = wid >> 2, wc = wid & 3, fr = lane & 15, fq = lane >> 4;
    const int K = g.K, nt = K / BK;
    unsigned voffA[2], voffB[2];
#pragma unroll
    for (int i = 0; i < 2; ++i) { int R, C; stage_rc(tid * 16 + i * 8192, R, C); const int Rb = Epi::PERM ? ((R & ~31) + perm32(R & 31)) : R;
        voffA[i] = (unsigned)(R * (TA ? 256 : K) + C) * 2u; voffB[i] = (unsigned)(Rb * K + C) * 2u; }
    const size_t kstep = (size_t)(BK * 2);
    const size_t hstep = (size_t)HALF * K * 2;
    const size_t hstepA = TA ? (size_t)HALF * 256 * 2 : hstep;
#define PG8_KOFF(t) (TA ? ((size_t)((t) >> 2) * 131072 + (size_t)((t) & 3) * 128) : (size_t)(t) * kstep)
    const size_t tstep = 2 * hstep;
    const unsigned ldsw = (unsigned)wid * 1024u;
    const int aoff = lds_byte(wr * 64 + fr, fq * 8), boff = lds_byte(wc * 32 + fr, fq * 8);
#define PG8_SA(b, h) (((b) * 2 + (h)) * HTB)
#define PG8_SB(b, h) ((4 + (b) * 2 + (h)) * HTB)
#define PG8_STAGE(bufoff, gbase, voff) do { _Pragma("unroll") for (int _i = 0; _i < 2; ++_i) \
        __builtin_amdgcn_global_load_lds((const unsigned*)((const char*)(gbase) + (voff)[_i]), (PG8_LAS unsigned*)(lds + (bufoff) + ldsw + _i * 8192), 16, 0, 0); } while (0)
#define PG8_LDA(dst, b, h) do { _Pragma("unroll") for (int m = 0; m < 4; ++m) _Pragma("unroll") for (int k = 0; k < 2; ++k) dst[m][k] = *(const PG8_LAS bf16x8*)(lds + PG8_SA(b, h) + aoff + m * 2048 + k * 1024); } while (0)
#define PG8_LDB(dst, b, h) do { _Pragma("unroll") for (int n = 0; n < 2; ++n) _Pragma("unroll") for (int k = 0; k < 2; ++k) dst[n][k] = *(const PG8_LAS bf16x8*)(lds + PG8_SB(b, h) + boff + n * 2048 + k * 1024); } while (0)
#define PG8_MMA(ai, bj, At, Bt) do { __builtin_amdgcn_s_setprio(1); _Pragma("unroll") for (int m = 0; m < 4; ++m) _Pragma("unroll") for (int n = 0; n < 2; ++n) _Pragma("unroll") for (int k = 0; k < 2; ++k) \
        acc[ai][bj][m][n] = __builtin_amdgcn_mfma_f32_16x16x32_bf16(Bt[n][k], At[m][k], acc[ai][bj][m][n], 0, 0, 0); __builtin_amdgcn_s_setprio(0); } while (0)
#define PG8_WAIT_V(n) asm volatile("s_waitcnt vmcnt(" #n ")" ::: "memory")
#define PG8_WAIT_L(n) asm volatile("s_waitcnt lgkmcnt(" #n ")" ::: "memory")
#define PG8_BAR __builtin_amdgcn_s_barrier()
#define PG8_SCHED __builtin_amdgcn_sched_barrier(0)
    Unit cur, nxt; int ui = 0;
    if (!S.next(0, cur)) return;
    f32x4 acc[2][2][4][2];
#pragma unroll
    for (int a = 0; a < 2; ++a)
#pragma unroll
        for (int b = 0; b < 2; ++b)
#pragma unroll
            for (int m = 0; m < 4; ++m)
#pragma unroll
                for (int n = 0; n < 2; ++n) acc[a][b][m][n] = (f32x4){0.f, 0.f, 0.f, 0.f};
    bf16x8 At[4][2], B0[2][2], B1[2][2];
    const char* cA = (const char*)g.A + (size_t)cur.pm * tstep; const char* cB = (const char*)g.Bt + (size_t)cur.pn * tstep;
    S.a_ready(cur);
    if constexpr (SP2) {
        PG8_STAGE(PG8_SB(0, 0), cB, voffB); PG8_STAGE(PG8_SB(0, 1), cB + hstep, voffB); PG8_STAGE(PG8_SA(0, 0), cA, voffA); PG8_STAGE(PG8_SA(0, 1), cA + hstepA, voffA);
        if (wr == 1) PG8_BAR;
        PG8_WAIT_V(2); PG8_BAR;
        PG8_STAGE(PG8_SB(1, 0), cB + kstep, voffB); PG8_STAGE(PG8_SA(1, 0), cA + kstep, voffA); PG8_STAGE(PG8_SB(1, 1), cB + hstep + kstep, voffB);
        PG8_WAIT_V(6); PG8_BAR;
    } else {
        PG8_STAGE(PG8_SB(0, 0), cB, voffB); PG8_STAGE(PG8_SA(0, 0), cA, voffA); PG8_STAGE(PG8_SB(0, 1), cB + hstep, voffB); PG8_STAGE(PG8_SA(0, 1), cA + hstepA, voffA);
        if (wr == 1) PG8_BAR;
        PG8_WAIT_V(4); PG8_BAR;
        PG8_STAGE(PG8_SB(1, 0), cB + kstep, voffB); PG8_STAGE(PG8_SA(1, 0), cA + kstep, voffA); PG8_STAGE(PG8_SB(1, 1), cB + hstep + kstep, voffB);
        PG8_WAIT_V(6); PG8_BAR;
    }
    for (;;) {
        const bool has_next = S.next(ui + 1, nxt);
        const char* nA = has_next ? (const char*)g.A + (size_t)nxt.pm * tstep : cA; const char* nB = has_next ? (const char*)g.Bt + (size_t)nxt.pn * tstep : cB;
        for (int t = 0; t < nt; t += 2) {
            const bool last = (t == nt - 2);
            const char* a1 = cA + PG8_KOFF(t + 1);
            const char* a2 = last ? nA : cA + PG8_KOFF(t + 2); const char* b2 = last ? nB : cB + (size_t)(t + 2) * kstep;
            const char* a3 = a2 + kstep; const char* b3 = b2 + kstep;
            if (last && has_next) S.a_ready(nxt);
            if constexpr (SP2) {
            PG8_LDB(B0, 0, 0); PG8_LDB(B1, 0, 1); PG8_SCHED; PG8_LDA(At, 0, 0); PG8_STAGE(PG8_SA(1, 1), a1 + hstepA, voffA);
            PG8_WAIT_V(8); PG8_WAIT_L(0); PG8_BAR; PG8_MMA(0, 0, At, B0); PG8_MMA(0, 1, At, B1); PG8_BAR; PG8_SCHED;
            PG8_LDA(At, 0, 1); PG8_STAGE(PG8_SB(0, 0), b2, voffB); PG8_STAGE(PG8_SB(0, 1), b2 + hstep, voffB); PG8_STAGE(PG8_SA(0, 0), a2, voffA);
            PG8_WAIT_V(8); PG8_WAIT_L(0); PG8_BAR; PG8_MMA(1, 0, At, B0); PG8_MMA(1, 1, At, B1); PG8_BAR; PG8_SCHED;
            PG8_LDB(B0, 1, 0); PG8_LDB(B1, 1, 1); PG8_SCHED; PG8_LDA(At, 1, 0); PG8_STAGE(PG8_SA(0, 1), a2 + hstepA, voffA);
            PG8_WAIT_V(8); PG8_WAIT_L(0); PG8_BAR; PG8_MMA(0, 0, At, B0); PG8_MMA(0, 1, At, B1); PG8_BAR; PG8_SCHED;
            PG8_LDA(At, 1, 1); PG8_STAGE(PG8_SB(1, 0), b3, voffB); PG8_STAGE(PG8_SB(1, 1), b3 + hstep, voffB); PG8_STAGE(PG8_SA(1, 0), a3, voffA);
            PG8_WAIT_V(8); PG8_WAIT_L(0); PG8_BAR; PG8_MMA(1, 0, At, B0); PG8_MMA(1, 1, At, B1); PG8_BAR; PG8_SCHED;
            } else {
            PG8_LDB(B0, 0, 0); PG8_SCHED; PG8_LDA(At, 0, 0); PG8_STAGE(PG8_SA(1, 1), a1 + hstepA, voffA);
            PG8_WAIT_L(8); PG8_BAR; PG8_WAIT_L(0); PG8_MMA(0, 0, At, B0); PG8_BAR; PG8_SCHED;
            PG8_LDB(B1, 0, 1); PG8_STAGE(PG8_SB(0, 0), b2, voffB);
            PG8_BAR; PG8_WAIT_L(0); PG8_MMA(0, 1, At, B1); PG8_BAR;
            PG8_LDA(At, 0, 1); PG8_STAGE(PG8_SA(0, 0), a2, voffA);
            PG8_BAR; PG8_WAIT_L(0); PG8_MMA(1, 0, At, B0); PG8_BAR; PG8_SCHED;
            PG8_STAGE(PG8_SB(0, 1), b2 + hstep, voffB);
            PG8_WAIT_V(6); PG8_BAR; PG8_MMA(1, 1, At, B1); PG8_BAR;
            PG8_LDB(B0, 1, 0); PG8_SCHED; PG8_LDA(At, 1, 0); PG8_STAGE(PG8_SA(0, 1), a2 + hstepA, voffA);
            PG8_WAIT_L(8); PG8_BAR; PG8_WAIT_L(0); PG8_MMA(0, 0, At, B0); PG8_BAR; PG8_SCHED;
            PG8_LDB(B1, 1, 1); PG8_STAGE(PG8_SB(1, 0), b3, voffB);
            PG8_BAR; PG8_WAIT_L(0); PG8_MMA(0, 1, At, B1); PG8_BAR;
            PG8_LDA(At, 1, 1); PG8_STAGE(PG8_SA(1, 0), a3, voffA);
            PG8_BAR; PG8_WAIT_L(0); PG8_MMA(1, 0, At, B0); PG8_BAR; PG8_SCHED;
            PG8_STAGE(PG8_SB(1, 1), b3 + hstep, voffB);
            PG8_WAIT_V(6); PG8_BAR; PG8_MMA(1, 1, At, B1); PG8_BAR;
            }
        }
        if constexpr (ALIGN_EPI) { if (wr == 0) PG8_BAR; }
        if constexpr (!Epi::AFTER_DRAIN) { E(acc, cur, wr, wc, fr, fq, ui); S.done(cur); }
        if (!has_next) break;
#pragma unroll
        for (int a = 0; a < 2; ++a)
#pragma unroll
            for (int b = 0; b < 2; ++b)
#pragma unroll
                for (int m = 0; m < 4; ++m)
#pragma unroll
                    for (int n = 0; n < 2; ++n) acc[a][b][m][n] = (f32x4){0.f, 0.f, 0.f, 0.f};
        cur = nxt; cA = nA; cB = nB; ++ui;
        if constexpr (ALIGN_EPI) { if (wr == 1) PG8_BAR; }
    }
    PG8_WAIT_V(0);
    if constexpr (!ALIGN_EPI) { if (wr == 0) PG8_BAR; }
    PG8_BAR;
    if constexpr (Epi::AFTER_DRAIN) { E.fused(acc, cur, wr, wc, fr, fq, lds, wid, lane); S.done(cur); }
#undef PG8_SA
#undef PG8_SB
#undef PG8_STAGE
#undef PG8_LDA
#undef PG8_LDB
#undef PG8_MMA
#undef PG8_WAIT_V
#undef PG8_WAIT_L
#undef PG8_BAR
#undef PG8_SCHED
#undef PG8_KOFF
}
}

constexpr int DM = 2048, NBATCH = 4, T = 4096, M = NBATCH * T, DEPTH = 2;
constexpr int HD = 128, AH = 6, BH = 4, CH = 6;
constexpr int INW = 6936, INWP = 7168;
constexpr int PA_Q = 0, PA_K = 768, PA_V = 1536, PB_Q = 2304, PB_K = 2816, PB_V = 3328, PC_QK = 3840, PC_V = 5376, PC_O = 6144, PC_G = 6912;
constexpr int MEML = 256, XH = 4, XHD = 512, DFF = 8192, NCH = 32, LC = 128;
constexpr float EPS = 1e-6f, LOG2E = 1.4426950408889634f, LN2 = 0.6931471805599453f;

#define GAS __attribute__((address_space(1)))
#define LAS __attribute__((address_space(3)))
typedef unsigned short bf16;
typedef unsigned v4u __attribute__((ext_vector_type(4)));
typedef float f32x4 __attribute__((ext_vector_type(4)));
typedef float f32x16 __attribute__((ext_vector_type(16)));
typedef short bf16x8 __attribute__((ext_vector_type(8)));
typedef short s16x4 __attribute__((ext_vector_type(4)));
typedef GAS unsigned gu32;
#define RLX_AGENT __ATOMIC_RELAXED, __HIP_MEMORY_SCOPE_AGENT
#define LDS_WAIT() asm volatile("s_waitcnt lgkmcnt(0)" ::: "memory")
#define VM_WAIT() asm volatile("s_waitcnt vmcnt(0)" ::: "memory")
#define SBAR() __builtin_amdgcn_sched_barrier(0)
__device__ __forceinline__ unsigned f2bf(float f) { unsigned u = __builtin_bit_cast(unsigned, f); return (u + 0x7fffu + ((u >> 16) & 1u)) >> 16; }
__device__ __forceinline__ unsigned pk2(float lo, float hi) { return f2bf(lo) | (f2bf(hi) << 16); }
__device__ __forceinline__ float bf2f(unsigned short b) { return __builtin_bit_cast(float, (unsigned)b << 16); }
__device__ __forceinline__ unsigned cvtpk(float lo, float hi) { unsigned r; asm volatile("v_cvt_pk_bf16_f32 %0, %1, %2" : "=v"(r) : "v"(lo), "v"(hi)); return r; }
__device__ __forceinline__ float ex2(float x) { return __builtin_amdgcn_exp2f(x); }
__device__ __forceinline__ bf16x8 pack8(const float* f) { v4u w; w.x = cvtpk(f[0], f[1]); w.y = cvtpk(f[2], f[3]); w.z = cvtpk(f[4], f[5]); w.w = cvtpk(f[6], f[7]); return __builtin_bit_cast(bf16x8, w); }
__device__ __forceinline__ bf16x8 scale8(bf16x8 q, float s) { float f[8];
#pragma unroll
    for (int j = 0; j < 8; ++j) f[j] = bf2f((unsigned short)q[j]) * s;
    return pack8(f); }

#define KSWZ(row, colB) ((row) * 256 + ((colB) ^ (((row) & 7) << 4)))
__device__ __forceinline__ int crow(int r, int hi) { return (r & 3) + 8 * (r >> 2) + 4 * hi; }
__device__ __forceinline__ int v_st(int k, int c) { const int kk = (k & ~0xC) | ((k & 4) << 1) | ((k & 8) >> 1); return ((kk >> 3) * 4 + (c >> 5)) * 512 + ((kk & 7) * 32 + (c & 31)) * 2; }
__device__ __forceinline__ int v_rd_base(int lane) { return ((lane & 3) << 3) | (((lane >> 2) & 3) << 6) | (((lane >> 4) & 1) << 5) | (((lane >> 5) & 1) << 8); }
constexpr int v_rd_off(int d0, int ks, int half) { return d0 * 512 + ks * 4096 + half * 2048; }
template <int OFF> __device__ __forceinline__ s16x4 tr_read(int vb) { s16x4 r; asm volatile("ds_read_b64_tr_b16 %0, %1 offset:%2" : "=&v"(r) : "v"(vb), "i"(OFF) : "memory"); return r; }
#define PK8(L, H) (bf16x8){L[0], L[1], L[2], L[3], H[0], H[1], H[2], H[3]}
__device__ __forceinline__ int lds_addr(const LAS void* p) { return (int)(unsigned)(size_t)p; }

template <int ND, bool ZERO>
__device__ __forceinline__ void qkt(f32x16& p0, f32x16& p1, const LAS char* Ks, const bf16x8* qr, int cboff, int r32, int hi) {
    if (ZERO) {
#pragma unroll
        for (int r = 0; r < 16; ++r) { p0[r] = 0.f; p1[r] = 0.f; } }
#pragma unroll
    for (int d0 = 0; d0 < ND; ++d0) { const int cb = cboff + (d0 * 16 + hi * 8) * 2;
        const bf16x8 b0 = *(const LAS bf16x8*)(Ks + KSWZ(r32, cb));
        const bf16x8 b1 = *(const LAS bf16x8*)(Ks + KSWZ(32 + r32, cb));
        p0 = __builtin_amdgcn_mfma_f32_32x32x16_bf16(b0, qr[d0], p0, 0, 0, 0);
        p1 = __builtin_amdgcn_mfma_f32_32x32x16_bf16(b1, qr[d0], p1, 0, 0, 0); }
}
template <int ND>
__device__ __forceinline__ void qkt_asm(f32x16& p0, f32x16& p1, const int (&ka)[ND], int tile_off, const bf16x8* qr) {
    bf16x8 b0[ND], b1[ND];
#pragma unroll
    for (int d0 = 0; d0 < ND; ++d0) { const int ad = ka[d0] + tile_off;
        asm volatile("ds_read_b128 %0, %1" : "=&v"(b0[d0]) : "v"(ad) : "memory");
        asm volatile("ds_read_b128 %0, %1 offset:8192" : "=&v"(b1[d0]) : "v"(ad) : "memory"); }
    asm volatile("s_waitcnt lgkmcnt(0)" ::: "memory"); SBAR();
#pragma unroll
    for (int d0 = 0; d0 < ND; ++d0) {
        p0 = __builtin_amdgcn_mfma_f32_32x32x16_bf16(b0[d0], qr[d0], p0, 0, 0, 0);
        p1 = __builtin_amdgcn_mfma_f32_32x32x16_bf16(b1[d0], qr[d0], p1, 0, 0, 0); }
}
template <int D0> __device__ __forceinline__ void pv_one(f32x16& od, int vb, bf16x8 pa0, bf16x8 pa1, bf16x8 pa2, bf16x8 pa3) {
    const s16x4 l0 = tr_read<v_rd_off(D0, 0, 0)>(vb), h0 = tr_read<v_rd_off(D0, 0, 1)>(vb), l1 = tr_read<v_rd_off(D0, 1, 0)>(vb), h1 = tr_read<v_rd_off(D0, 1, 1)>(vb);
    const s16x4 l2 = tr_read<v_rd_off(D0, 2, 0)>(vb), h2 = tr_read<v_rd_off(D0, 2, 1)>(vb), l3 = tr_read<v_rd_off(D0, 3, 0)>(vb), h3 = tr_read<v_rd_off(D0, 3, 1)>(vb);
    asm volatile("s_waitcnt lgkmcnt(0)" ::: "memory"); SBAR();
    od = __builtin_amdgcn_mfma_f32_32x32x16_bf16(pa0, PK8(l0, h0), od, 0, 0, 0);
    od = __builtin_amdgcn_mfma_f32_32x32x16_bf16(pa1, PK8(l1, h1), od, 0, 0, 0);
    od = __builtin_amdgcn_mfma_f32_32x32x16_bf16(pa2, PK8(l2, h2), od, 0, 0, 0);
    od = __builtin_amdgcn_mfma_f32_32x32x16_bf16(pa3, PK8(l3, h3), od, 0, 0, 0);
}
template <int BASE> __device__ __forceinline__ bf16x8 pk4(const f32x16& P) {
    const unsigned a0 = cvtpk(P[BASE + 0], P[BASE + 1]), a1 = cvtpk(P[BASE + 2], P[BASE + 3]), b0 = cvtpk(P[BASE + 4], P[BASE + 5]), b1 = cvtpk(P[BASE + 6], P[BASE + 7]);
    auto r0 = __builtin_amdgcn_permlane32_swap(a0, b0, false, false); auto r1 = __builtin_amdgcn_permlane32_swap(a1, b1, false, false);
    v4u w = {r0[0], r1[0], r0[1], r1[1]}; return __builtin_bit_cast(bf16x8, w);
}
__device__ __forceinline__ float xhalf_max(float v) { auto rr = __builtin_amdgcn_permlane32_swap(__float_as_uint(v), __float_as_uint(v), false, false); return fmaxf(__uint_as_float(rr[0]), __uint_as_float(rr[1])); }
__device__ __forceinline__ float xhalf_sum(float v) { auto rr = __builtin_amdgcn_permlane32_swap(__float_as_uint(v), __float_as_uint(v), false, false); return __uint_as_float(rr[0]) + __uint_as_float(rr[1]); }
__device__ __forceinline__ float sm_update(f32x16& p0, f32x16& p1, float& m, float& l) {
    float pmax = p0[0];
#pragma unroll
    for (int r = 1; r < 16; ++r) pmax = fmaxf(pmax, p0[r]);
#pragma unroll
    for (int r = 0; r < 16; ++r) pmax = fmaxf(pmax, p1[r]);
    pmax = xhalf_max(pmax);
    const float mn = fmaxf(m, pmax), alpha = ex2(m - mn); m = mn;
    float ps = 0.f;
#pragma unroll
    for (int r = 0; r < 16; ++r) { p0[r] = ex2(p0[r] - mn); ps += p0[r]; }
#pragma unroll
    for (int r = 0; r < 16; ++r) { p1[r] = ex2(p1[r] - mn); ps += p1[r]; }
    ps = xhalf_sum(ps);
    l = l * alpha + ps; return alpha;
}
__device__ __forceinline__ float sm_update2(f32x16& p0, f32x16& p1, f32x16& p2, f32x16& p3, float& m, float& l) {
    float pmax = p0[0];
#pragma unroll
    for (int r = 0; r < 16; ++r) { pmax = fmaxf(pmax, fmaxf(p0[r], p1[r])); pmax = fmaxf(pmax, fmaxf(p2[r], p3[r])); }
    pmax = xhalf_max(pmax);
    const float mn = fmaxf(m, pmax), alpha = ex2(m - mn); m = mn;
    float ps = 0.f, ps2 = 0.f;
#pragma unroll
    for (int r = 0; r < 16; ++r) { p0[r] = ex2(p0[r] - mn); ps += p0[r]; p2[r] = ex2(p2[r] - mn); ps2 += p2[r]; }
#pragma unroll
    for (int r = 0; r < 16; ++r) { p1[r] = ex2(p1[r] - mn); ps += p1[r]; p3[r] = ex2(p3[r] - mn); ps2 += p3[r]; }
    ps = xhalf_sum(ps + ps2);
    l = l * alpha + ps; return alpha;
}
template <int NO> __device__ __forceinline__ void row_scale(f32x16 (&o)[NO], float f, LAS float* al, int r32, int hi) {
    if (hi == 0) al[r32] = f;
    LDS_WAIT();
#pragma unroll
    for (int r = 0; r < 16; ++r) { const float a = al[crow(r, hi)];
#pragma unroll
        for (int d = 0; d < NO; ++d) o[d][r] *= a; }
    LDS_WAIT();
}
struct Stg2 { bf16x8 a, b; };
__device__ __forceinline__ void stg_store_k(LAS char* buf, const Stg2& s, int sr, int sc) { *(LAS bf16x8*)(buf + KSWZ(sr, sc * 2)) = s.a; *(LAS bf16x8*)(buf + KSWZ(32 + sr, sc * 2)) = s.b; }
__device__ __forceinline__ void stg_store_v(LAS char* buf, const Stg2& s, int sr, int sc) { *(LAS bf16x8*)(buf + v_st(sr, sc)) = s.a; *(LAS bf16x8*)(buf + v_st(32 + sr, sc)) = s.b; }

__device__ __forceinline__ void k_slot(int s, int& row, int& col) { row = s >> 4; col = ((s & 15) ^ (row & 7)) * 8; }
__device__ __forceinline__ void v_slot(int s, int& row, int& col) { const int sub = s >> 5, w32 = s & 31, kk = (sub >> 2) * 8 + (w32 >> 2); col = (sub & 3) * 32 + (w32 & 3) * 8; row = (kk & ~0xC) | ((kk & 4) << 1) | ((kk & 8) >> 1); }
__device__ __forceinline__ void glds16(const bf16* g, LAS char* l) { __builtin_amdgcn_global_load_lds((const unsigned*)g, (LAS unsigned*)l, 16, 0, 0); }
#define WAIT_VM(n) asm volatile("s_waitcnt vmcnt(" #n ")" ::: "memory")
#define WG_BAR() do { asm volatile("s_waitcnt lgkmcnt(0)" ::: "memory"); __builtin_amdgcn_s_barrier(); asm volatile("" ::: "memory"); } while (0)

__device__ __forceinline__ float alibi_slope(int h, int nh) { return exp2f(-8.f * (float)(h + 1) / (float)nh); }

__device__ __forceinline__ void diffattn_unit(LAS char* lds, const bf16* __restrict__ proj, bf16* __restrict__ heads, const float* __restrict__ hng, const LAS float* lamp  , const float* __restrict__ nrm, int nblk,
                                              int b, int h, int qb) {
    int tid_ = threadIdx.x; asm volatile("" : "+v"(tid_)); const int tid = tid_, wid = __builtin_amdgcn_readfirstlane(tid >> 6), lane = tid & 63, r32 = lane & 31, hi = lane >> 5;
    const int st = wid >> 2, rg = wid & 3;
    LAS float* al = (LAS float*)(lds + 132096) + wid * 64;
    const size_t rowbase = (size_t)b * T;
    const int Q0 = qb * 128, q0w = Q0 + rg * 32, qpos = q0w + r32;
    const float sl2 = alibi_slope(h, BH) * LOG2E;
    int j_lo, j_hi;
    {   float m0 = 0.f, m1 = 0.f, m2 = 0.f, m3 = 0.f;
        for (int k = lane; k < nblk; k += 64) { const float* p = nrm + (size_t)k * 64 + b * 16 + h * 2; m0 = fmaxf(m0, p[0]); m1 = fmaxf(m1, p[1]); m2 = fmaxf(m2, p[8]); m3 = fmaxf(m3, p[9]); }
#pragma unroll
        for (int o = 1; o < 64; o <<= 1) { m0 = fmaxf(m0, __shfl_xor(m0, o)); m1 = fmaxf(m1, __shfl_xor(m1, o)); m2 = fmaxf(m2, __shfl_xor(m2, o)); m3 = fmaxf(m3, __shfl_xor(m3, o)); }
        const float B = 1.01f * sqrtf(fmaxf(m0 * m2, m1 * m3)) + 0.01f;
        const float dskip = (2.f * B + 42.f) / sl2;
        const float x = ((float)(Q0 - 63) - dskip) * (1.f / 64.f), y = ((float)(Q0 + 127) + dskip) * (1.f / 64.f);
        j_lo = x <= 0.f ? 0 : (int)ceilf(x); j_hi = y >= (float)(T / 64 - 1) ? T / 64 - 1 : (int)floorf(y);
        j_lo = __builtin_amdgcn_readfirstlane(j_lo); j_hi = __builtin_amdgcn_readfirstlane(j_hi);
    }
    bf16x8 qr[4];
    { const bf16* qp = proj + (rowbase + qpos) * INWP + PB_Q + h * 128 + st * 64 + hi * 8;
#pragma unroll
      for (int d0 = 0; d0 < 4; ++d0) qr[d0] = *(const bf16x8*)(qp + d0 * 16); }
    const bf16* ksrc[2]; const bf16* vsrc[2];
#pragma unroll
    for (int i = 0; i < 2; ++i) { int rw, cl; k_slot((i * 8 + wid) * 64 + lane, rw, cl); ksrc[i] = proj + (rowbase + rw) * INWP + PB_K + h * 128 + cl;
        v_slot((i * 8 + wid) * 64 + lane, rw, cl); vsrc[i] = proj + (rowbase + rw) * INWP + PB_V + h * 128 + cl; }
    LAS char* Vb = lds + 65536;
    const int vb0 = lds_addr(Vb) + v_rd_base(lane);
    const int ksw0 = KSWZ(r32, st * 128 + hi * 16), kbase = lds_addr(lds);
#define KA(d0) (kbase + (ksw0 ^ ((d0) << 5)))
#define B_ISSUE(tile, buf) do { const size_t ro_ = (size_t)(tile) * 64 * INWP; LAS char* kd_ = lds + (buf) * 16384 + wid * 1024; LAS char* vd_ = Vb + (buf) * 16384 + wid * 1024; \
        glds16(ksrc[0] + ro_, kd_); glds16(ksrc[1] + ro_, kd_ + 8192); glds16(vsrc[0] + ro_, vd_); glds16(vsrc[1] + ro_, vd_ + 8192); } while (0)
#define B_BIAS(P0, P1, J) do { const float dqh_ = (float)(qpos - (J) * 64 - 4 * hi); \
        if ((J) * 64 + 63 < q0w) { const float Lh_ = -sl2 * dqh_;        \
            _Pragma("unroll") for (int r = 0; r < 16; ++r) { const float c0 = (float)((r & 3) + 8 * (r >> 2)); P0[r] = fmaf(sl2, c0, Lh_); P1[r] = fmaf(sl2, c0 + 32.f, Lh_); } } \
        else if ((J) * 64 > q0w + 31) { const float Lh_ = sl2 * dqh_;    \
            _Pragma("unroll") for (int r = 0; r < 16; ++r) { const float c0 = (float)((r & 3) + 8 * (r >> 2)); P0[r] = fmaf(-sl2, c0, Lh_); P1[r] = fmaf(-sl2, c0 + 32.f, Lh_); } } \
        else { _Pragma("unroll") for (int r = 0; r < 16; ++r) { const float c0 = (float)((r & 3) + 8 * (r >> 2)); P0[r] = -sl2 * fabsf(dqh_ - c0); P1[r] = -sl2 * fabsf(dqh_ - 32.f - c0); } } } while (0)
    float l = 0.f; f32x16 o[4];
#pragma unroll
    for (int d = 0; d < 4; ++d)
#pragma unroll
        for (int r = 0; r < 16; ++r) o[d][r] = 0.f;
    const int nt = j_hi - j_lo + 1;
    asm volatile("" :: "v"(qr[0]), "v"(qr[1]), "v"(qr[2]), "v"(qr[3]));
#define WAIT_LGKM(n) asm volatile("s_waitcnt lgkmcnt(" #n ")" ::: "memory")
#define B_TR(D0, L) do { L[0] = tr_read<v_rd_off(D0, 0, 0)>(vb_); L[1] = tr_read<v_rd_off(D0, 0, 1)>(vb_); L[2] = tr_read<v_rd_off(D0, 1, 0)>(vb_); L[3] = tr_read<v_rd_off(D0, 1, 1)>(vb_); \
        L[4] = tr_read<v_rd_off(D0, 2, 0)>(vb_); L[5] = tr_read<v_rd_off(D0, 2, 1)>(vb_); L[6] = tr_read<v_rd_off(D0, 3, 0)>(vb_); L[7] = tr_read<v_rd_off(D0, 3, 1)>(vb_); } while (0)
#define B_MM(D0, L, P0_, P1_, P2_, P3_) do { o[D0] = __builtin_amdgcn_mfma_f32_32x32x16_bf16(P0_, PK8(L[0], L[1]), o[D0], 0, 0, 0); o[D0] = __builtin_amdgcn_mfma_f32_32x32x16_bf16(P1_, PK8(L[2], L[3]), o[D0], 0, 0, 0); \
        o[D0] = __builtin_amdgcn_mfma_f32_32x32x16_bf16(P2_, PK8(L[4], L[5]), o[D0], 0, 0, 0); o[D0] = __builtin_amdgcn_mfma_f32_32x32x16_bf16(P3_, PK8(L[6], L[7]), o[D0], 0, 0, 0); } while (0)
#define B_CHUNK(P, BASE, PAOUT) do { _Pragma("unroll") for (int r = BASE; r < BASE + 8; ++r) { P[r] = ex2(P[r]); ps_ += P[r]; } PAOUT = pk4<BASE>(P); } while (0)
#define B_ITER(t_, C0, C1, C2, C3, N0, N1, N2, N3) do { const int j_ = j_lo + (t_), bs_ = (t_) & 3, bn_ = ((t_) + 1) & 3; const bool more_ = (t_) + 1 < nt; \
        if (more_) { if ((t_) + 2 < nt) WAIT_VM(4); else WAIT_VM(0); }        \
        WG_BAR();                                                             \
        if ((t_) + 3 < nt) B_ISSUE(j_ + 3, (bs_ + 3) & 3); \
        f32x16 pn0, pn1; float ps_ = 0.f; \
        if (more_ && md_ != 4) { B_BIAS(pn0, pn1, j_ + 1); if (md_ != 3) { { int k2[2] = {KA(0), KA(1)}; qkt_asm<2>(pn0, pn1, k2, bn_ * 16384, qr); } { int k2[2] = {KA(2), KA(3)}; qkt_asm<2>(pn0, pn1, k2, bn_ * 16384, qr + 2); } } } \
        const int vb_ = vb0 + bs_ * 16384; s16x4 LA[8]; const bool pv_ = md_ != 2 && md_ != 4, ch_ = more_ && md_ != 4 && md_ != 5; \
        if (pv_) { B_TR(0, LA); WAIT_LGKM(0); SBAR(); B_MM(0, LA, C0, C1, C2, C3); B_TR(1, LA); } SBAR(); if (ch_) B_CHUNK(pn0, 0, N0); \
        if (pv_) { WAIT_LGKM(0); SBAR(); B_MM(1, LA, C0, C1, C2, C3); B_TR(2, LA); } SBAR(); if (ch_) B_CHUNK(pn0, 8, N1); \
        if (pv_) { WAIT_LGKM(0); SBAR(); B_MM(2, LA, C0, C1, C2, C3); B_TR(3, LA); } SBAR(); if (ch_) B_CHUNK(pn1, 0, N2); \
        if (pv_) { WAIT_LGKM(0); SBAR(); B_MM(3, LA, C0, C1, C2, C3); } SBAR(); if (ch_) B_CHUNK(pn1, 8, N3); \
        l += ps_; } while (0)
#if MK_B_MODE
    {
#define md_ MK_B_MODE
    B_ISSUE(j_lo, 0);
    if (nt > 1) B_ISSUE(j_lo + 1, 1);
    if (nt > 2) B_ISSUE(j_lo + 2, 2);
    bf16x8 a0, a1, a2, a3, b0 = {0, 0, 0, 0, 0, 0, 0, 0}, b1 = b0, b2 = b0, b3 = b0;
    {   f32x16 pc0, pc1; float ps_ = 0.f;
        if (nt > 2) WAIT_VM(8); else if (nt > 1) WAIT_VM(4); else WAIT_VM(0);
        WG_BAR();
        B_BIAS(pc0, pc1, j_lo);
        { int k2[2] = {KA(0), KA(1)}; qkt_asm<2>(pc0, pc1, k2, 0, qr); } { int k2[2] = {KA(2), KA(3)}; qkt_asm<2>(pc0, pc1, k2, 0, qr + 2); }
        B_CHUNK(pc0, 0, a0); B_CHUNK(pc0, 8, a1); B_CHUNK(pc1, 0, a2); B_CHUNK(pc1, 8, a3);
        l += ps_; }
    for (int t = 0; t < nt; t += 2) {
        B_ITER(t, a0, a1, a2, a3, b0, b1, b2, b3);
        if (t + 1 < nt) B_ITER(t + 1, b0, b1, b2, b3, a0, a1, a2, a3);
    }

#undef md_
        WG_BAR(); l = 0.f;
#pragma unroll
        for (int d = 0; d < 4; ++d)
#pragma unroll
            for (int r = 0; r < 16; ++r) o[d][r] = 0.f;
    }
#endif
    {
#define md_ 0
    B_ISSUE(j_lo, 0);
    if (nt > 1) B_ISSUE(j_lo + 1, 1);
    if (nt > 2) B_ISSUE(j_lo + 2, 2);
    bf16x8 a0, a1, a2, a3, b0 = {0, 0, 0, 0, 0, 0, 0, 0}, b1 = b0, b2 = b0, b3 = b0;
    {   f32x16 pc0, pc1; float ps_ = 0.f;
        if (nt > 2) WAIT_VM(8); else if (nt > 1) WAIT_VM(4); else WAIT_VM(0);
        WG_BAR();
        B_BIAS(pc0, pc1, j_lo);
        { int k2[2] = {KA(0), KA(1)}; qkt_asm<2>(pc0, pc1, k2, 0, qr); } { int k2[2] = {KA(2), KA(3)}; qkt_asm<2>(pc0, pc1, k2, 0, qr + 2); }
        B_CHUNK(pc0, 0, a0); B_CHUNK(pc0, 8, a1); B_CHUNK(pc1, 0, a2); B_CHUNK(pc1, 8, a3);
        l += ps_; }
    for (int t = 0; t < nt; t += 2) {
        B_ITER(t, a0, a1, a2, a3, b0, b1, b2, b3);
        if (t + 1 < nt) B_ITER(t + 1, b0, b1, b2, b3, a0, a1, a2, a3);
    }

#undef md_
    }
#undef KA
#undef B_ITER
#undef B_CHUNK
#undef B_MM
#undef B_TR
#undef B_ISSUE
#undef B_BIAS
    WG_BAR();
    {
        int t2_ = threadIdx.x; asm volatile("" : "+v"(t2_)); const int lane = t2_ & 63, r32 = lane & 31, hi = lane >> 5; (void)lane;
    l = xhalf_sum(l);
    const float lam = lamp[1], hscale = lamp[2];
    row_scale<4>(o, (st ? lam : 1.f) / l, al, r32, hi);
    LAS float* X = (LAS float*)lds + rg * 4096;
    if (st == 1) {
#pragma unroll
        for (int d = 0; d < 4; ++d)
#pragma unroll
            for (int r = 0; r < 16; ++r) X[crow(r, hi) * 128 + d * 32 + r32] = o[d][r];
    }
    __syncthreads();
    if (st == 0) {
        float g[4];
#pragma unroll
        for (int d = 0; d < 4; ++d) g[d] = hng[(AH + h) * 128 + d * 32 + r32] * hscale;
#pragma unroll
        for (int r = 0; r < 16; ++r) { float ss = 0.f;
#pragma unroll
            for (int d = 0; d < 4; ++d) { o[d][r] -= X[crow(r, hi) * 128 + d * 32 + r32]; ss += o[d][r] * o[d][r]; }
            ss += __shfl_xor(ss, 1); ss += __shfl_xor(ss, 2); ss += __shfl_xor(ss, 4); ss += __shfl_xor(ss, 8); ss += __shfl_xor(ss, 16);
            const float rs = __builtin_amdgcn_rsqf(ss * (1.f / 128.f) + EPS);
            bf16* hp = heads + (rowbase + qb * 128 + rg * 32 + crow(r, hi)) * DM + (AH + h) * 128 + r32;
#pragma unroll
            for (int d = 0; d < 4; ++d) hp[d * 32] = (bf16)f2bf(o[d][r] * rs * g[d]); }
    }
    __syncthreads();
    }
}

__device__ __forceinline__ void dilattn_unit(LAS char* lds, const bf16* __restrict__ proj, bf16* __restrict__ og, float* __restrict__ lse, int b, int h, int cfg, int rho, int seg, int mode = 0) {
    int tid_ = threadIdx.x; asm volatile("" : "+v"(tid_)); const int tid = tid_, wid = __builtin_amdgcn_readfirstlane(tid >> 6), lane = tid & 63, r32 = lane & 31, hi = lane >> 5;
    const int rsh = 2 * cfg, rr = 1 << rsh, nsub = T >> rsh;
    LAS char* Vb = lds + 65536; LAS float* al = (LAS float*)(lds + 132096) + wid * 64;
    const size_t rowbase = (size_t)b * T;
    const int base = seg * 256, qn = base + wid * 32 + r32, qblk = wid >> 1;
    const int qtok = qn * rr + rho;
    bf16x8 qr[8];
    { const bf16* qp = proj + (rowbase + qtok) * INWP + PA_Q + h * 128 + hi * 8;
#pragma unroll
      for (int d0 = 0; d0 < 8; ++d0) qr[d0] = *(const bf16x8*)(qp + d0 * 16); }
    int krow[2], vrow[2]; const bf16* kcolp[2]; const bf16* vcolp[2];
#pragma unroll
    for (int i = 0; i < 2; ++i) { int rw, cl; k_slot((i * 8 + wid) * 64 + lane, rw, cl); krow[i] = rw; kcolp[i] = proj + rowbase * INWP + PA_K + h * 128 + cl;
        v_slot((i * 8 + wid) * 64 + lane, rw, cl); vrow[i] = rw; vcolp[i] = proj + rowbase * INWP + PA_V + h * 128 + cl; }
#define DIL_ISSUE(kt, buf) do { const int k00_ = base + 64 * ((kt) - 1); \
        _Pragma("unroll") for (int i = 0; i < 2; ++i) { int kk_ = k00_ + krow[i]; kk_ = kk_ < 0 ? 0 : (kk_ >= nsub ? nsub - 1 : kk_); glds16(kcolp[i] + (size_t)(kk_ * rr + rho) * INWP, lds + (buf) * 16384 + (i * 8 + wid) * 1024); } \
        _Pragma("unroll") for (int i = 0; i < 2; ++i) { int kk_ = k00_ + vrow[i]; kk_ = kk_ < 0 ? 0 : (kk_ >= nsub ? nsub - 1 : kk_); glds16(vcolp[i] + (size_t)(kk_ * rr + rho) * INWP, Vb + (buf) * 16384 + (i * 8 + wid) * 1024); } } while (0)
    const int vb0 = lds_addr(Vb) + v_rd_base(lane);
    int ka[8];
#pragma unroll
    for (int d0 = 0; d0 < 8; ++d0) ka[d0] = lds_addr(lds) + KSWZ(r32, (d0 * 16 + hi * 8) * 2);
    float m = -1e30f, l = 0.f; f32x16 o[4];
#pragma unroll
    for (int d = 0; d < 4; ++d)
#pragma unroll
        for (int r = 0; r < 16; ++r) o[d][r] = 0.f;
    const float sl2 = alibi_slope(h, AH) * LOG2E * (float)rr;
    asm volatile("" :: "v"(qr[0]), "v"(qr[1]), "v"(qr[2]), "v"(qr[3]), "v"(qr[4]), "v"(qr[5]), "v"(qr[6]), "v"(qr[7]));
    DIL_ISSUE(0, 0); DIL_ISSUE(1, 1); DIL_ISSUE(2, 2); DIL_ISSUE(3, 3);
#define DIL_SCORE(P0, P1, kt) do { const float dqh_ = (float)(qn - (base + 64 * ((kt) - 1)) - 4 * hi); const int rel_ = (kt) - qblk; \
        if (rel_ == 1) { _Pragma("unroll") for (int r = 0; r < 16; ++r) { const float c0 = (float)((r & 3) + 8 * (r >> 2)); P0[r] = -sl2 * fabsf(dqh_ - c0); P1[r] = -sl2 * fabsf(dqh_ - 32.f - c0); } } \
        else if (rel_ == 0) { _Pragma("unroll") for (int r = 0; r < 16; ++r) { const float c0 = (float)((r & 3) + 8 * (r >> 2)); const float d0v = dqh_ - c0, d1v = dqh_ - 32.f - c0; \
            P0[r] = d0v <= 64.f ? -sl2 * d0v : -INFINITY; P1[r] = d1v <= 64.f ? -sl2 * d1v : -INFINITY; } } \
        else { _Pragma("unroll") for (int r = 0; r < 16; ++r) { const float c0 = (float)((r & 3) + 8 * (r >> 2)); const float d0v = dqh_ - c0, d1v = dqh_ - 32.f - c0; \
            P0[r] = d0v >= -64.f ? sl2 * d0v : -INFINITY; P1[r] = d1v >= -64.f ? sl2 * d1v : -INFINITY; } } \
        { int k4[4] = {ka[0], ka[1], ka[2], ka[3]}; qkt_asm<4>(P0, P1, k4, ((kt) & 3) * 16384, qr); } \
        { int k4[4] = {ka[4], ka[5], ka[6], ka[7]}; qkt_asm<4>(P0, P1, k4, ((kt) & 3) * 16384, qr + 4); } } while (0)
#define DIL_PV(P0, P1, kt) do { const bf16x8 pa0 = pk4<0>(P0), pa1 = pk4<8>(P0), pa2 = pk4<0>(P1), pa3 = pk4<8>(P1); const int vb = vb0 + ((kt) & 3) * 16384; \
        pv_one<0>(o[0], vb, pa0, pa1, pa2, pa3); pv_one<1>(o[1], vb, pa0, pa1, pa2, pa3); pv_one<2>(o[2], vb, pa0, pa1, pa2, pa3); pv_one<3>(o[3], vb, pa0, pa1, pa2, pa3); } while (0)
#define DIL_ONE(kt_) do { const int kt = (kt_); const int k0_ = base + 64 * (kt - 1); if (k0_ >= 0 && k0_ < nsub) { f32x16 p0, p1; DIL_SCORE(p0, p1, kt); \
            const float alpha = sm_update(p0, p1, m, l); if (__any(alpha < 1.f)) row_scale<4>(o, alpha, al, r32, hi); \
            DIL_PV(p0, p1, kt); } } while (0)
    if (mode == 1) { WAIT_VM(0); WG_BAR(); return; }
    WAIT_VM(0); WG_BAR(); DIL_ONE(qblk);
    WG_BAR(); DIL_ISSUE(4, 0); if (qblk < 3) DIL_ONE(qblk + 1);
    WAIT_VM(0); WG_BAR(); DIL_ISSUE(5, 1); DIL_ONE(qblk < 3 ? qblk + 2 : 4);
    WAIT_VM(0); WG_BAR(); if (qblk == 3) DIL_ONE(5);
#undef DIL_ONE
#undef DIL_PV
#undef DIL_SCORE
#undef DIL_ISSUE
    WG_BAR();
    row_scale<4>(o, 1.f / l, al, r32, hi);
    if (mode == 2) { if (l == 1.2345e30f) og[0] = 0; return; }
    if (hi == 0) lse[((size_t)cfg * M + rowbase + qtok) * AH + h] = (m + __log2f(l)) * LN2;
    bf16* ob = og + ((size_t)cfg * M + rowbase) * (AH * HD) + h * 128 + r32;
#pragma unroll
    for (int r = 0; r < 16; ++r) { const int tok = (base + wid * 32 + crow(r, hi)) * rr + rho;
#pragma unroll
        for (int d = 0; d < 4; ++d) ob[(size_t)tok * (AH * HD) + d * 32] = (bf16)f2bf(o[d][r]); }
}

__device__ __forceinline__ void xattn_unit(LAS char* lds, const bf16* __restrict__ xq, const bf16* __restrict__ kv, bf16* __restrict__ xa, int b, int h, int qb) {
    int tid_ = threadIdx.x; asm volatile("" : "+v"(tid_)); const int tid = tid_, wid = __builtin_amdgcn_readfirstlane(tid >> 6), lane = tid & 63, r32 = lane & 31, hi = lane >> 5;
    LAS char* Kb = lds; LAS char* Vb = lds + 32768; LAS float* al = (LAS float*)(lds + 65536) + wid * 64;
    const size_t row = (size_t)b * T + qb * 256 + wid * 32 + r32;
    const int sr = tid >> 4, sc = (tid & 15) * 8;
    const bf16* kbase = kv + ((size_t)b * MEML + sr) * (2 * DM) + h * XHD + sc;
    const bf16* vbase = kbase + DM;
    const bf16* qp = xq + row * DM + h * XHD + hi * 8;
    f32x16 s[4][2];
#pragma unroll
    for (int t = 0; t < 4; ++t)
#pragma unroll
        for (int r = 0; r < 16; ++r) { s[t][0][r] = 0.f; s[t][1][r] = 0.f; }
    Stg2 sg[2];
    sg[0].a = *(const bf16x8*)(kbase); sg[0].b = *(const bf16x8*)(kbase + (size_t)32 * 2 * DM);
    { const bf16* p = kbase + (size_t)64 * 2 * DM; sg[1].a = *(const bf16x8*)p; sg[1].b = *(const bf16x8*)(p + (size_t)32 * 2 * DM); }
    stg_store_k(Kb, sg[0], sr, sc);
    __syncthreads();
    bf16x8 qr[8];
#pragma unroll
    for (int i = 0; i < 16; ++i) { const int dc = i >> 2, kt = i & 3;
        if (kt == 0) {
#pragma unroll
            for (int d0 = 0; d0 < 8; ++d0) qr[d0] = *(const bf16x8*)(qp + dc * 128 + d0 * 16); }
        if (i + 2 < 16) { const int dc2 = (i + 2) >> 2, kt2 = (i + 2) & 3; const bf16* p = kbase + (size_t)(kt2 * 64) * 2 * DM + dc2 * 128; sg[i & 1].a = *(const bf16x8*)p; sg[i & 1].b = *(const bf16x8*)(p + (size_t)32 * 2 * DM); }
        asm volatile("" ::: "memory");
        qkt<8, false>(s[kt][0], s[kt][1], Kb + (i & 1) * 16384, qr, 0, r32, hi);
        if (i + 1 < 16) stg_store_k(Kb + ((i + 1) & 1) * 16384, sg[(i + 1) & 1], sr, sc);
        __syncthreads();
    }
    float mx = s[0][0][0];
#pragma unroll
    for (int t = 0; t < 4; ++t)
#pragma unroll
        for (int r = 0; r < 16; ++r) { mx = fmaxf(mx, s[t][0][r]); mx = fmaxf(mx, s[t][1][r]); }
    mx = xhalf_max(mx);
    float ps = 0.f;
#pragma unroll
    for (int t = 0; t < 4; ++t)
#pragma unroll
        for (int r = 0; r < 16; ++r) { s[t][0][r] = ex2(s[t][0][r] - mx); ps += s[t][0][r]; s[t][1][r] = ex2(s[t][1][r] - mx); ps += s[t][1][r]; }
    ps = xhalf_sum(ps);
    bf16x8 pa[4][4];
#pragma unroll
    for (int t = 0; t < 4; ++t) { pa[t][0] = pk4<0>(s[t][0]); pa[t][1] = pk4<8>(s[t][0]); pa[t][2] = pk4<0>(s[t][1]); pa[t][3] = pk4<8>(s[t][1]); }
    if (hi == 0) al[r32] = 1.f / ps;
    LDS_WAIT();
    float rl[16];
#pragma unroll
    for (int r = 0; r < 16; ++r) rl[r] = al[crow(r, hi)];
    const int vb0 = lds_addr(Vb) + v_rd_base(lane);
    sg[0].a = *(const bf16x8*)(vbase); sg[0].b = *(const bf16x8*)(vbase + (size_t)32 * 2 * DM);
    { const bf16* p = vbase + (size_t)64 * 2 * DM; sg[1].a = *(const bf16x8*)p; sg[1].b = *(const bf16x8*)(p + (size_t)32 * 2 * DM); }
    stg_store_v(Vb, sg[0], sr, sc);
    __syncthreads();
    f32x16 o[4];
#pragma unroll
    for (int i = 0; i < 16; ++i) { const int vc = i >> 2, kt = i & 3;
        if (kt == 0) {
#pragma unroll
            for (int d = 0; d < 4; ++d)
#pragma unroll
                for (int r = 0; r < 16; ++r) o[d][r] = 0.f; }
        if (i + 2 < 16) { const int vc2 = (i + 2) >> 2, kt2 = (i + 2) & 3; const bf16* p = vbase + (size_t)(kt2 * 64) * 2 * DM + vc2 * 128; sg[i & 1].a = *(const bf16x8*)p; sg[i & 1].b = *(const bf16x8*)(p + (size_t)32 * 2 * DM); }
        asm volatile("" ::: "memory");
        const int vb = vb0 + (i & 1) * 16384;
        pv_one<0>(o[0], vb, pa[kt][0], pa[kt][1], pa[kt][2], pa[kt][3]); pv_one<1>(o[1], vb, pa[kt][0], pa[kt][1], pa[kt][2], pa[kt][3]);
        pv_one<2>(o[2], vb, pa[kt][0], pa[kt][1], pa[kt][2], pa[kt][3]); pv_one<3>(o[3], vb, pa[kt][0], pa[kt][1], pa[kt][2], pa[kt][3]);
        if (kt == 3) {
            bf16* op = xa + ((size_t)b * T + qb * 256 + wid * 32) * DM + h * XHD + vc * 128 + r32;
#pragma unroll
            for (int r = 0; r < 16; ++r)
#pragma unroll
                for (int d = 0; d < 4; ++d) op[(size_t)crow(r, hi) * DM + d * 32] = (bf16)f2bf(o[d][r] * rl[r]);
        }
        if (i + 1 < 16) stg_store_v(Vb + ((i + 1) & 1) * 16384, sg[(i + 1) & 1], sr, sc);
        __syncthreads();
    }
}

__device__ __forceinline__ void mlstm_dc_units(LAS char* lds, const bf16* __restrict__ cqk, const bf16* __restrict__ proj, const float* __restrict__ GA, const LAS float* ML,
                                               bf16* __restrict__ dC, float* __restrict__ dn, int ufirst, int ustep, int utotal) {
    int tid_ = threadIdx.x; asm volatile("" : "+v"(tid_)); const int tid = tid_, wid = __builtin_amdgcn_readfirstlane(tid >> 6), lane = tid & 63, r32 = lane & 31, hi = lane >> 5;
    LAS char* KF = lds; LAS char* KB = lds + 32768; LAS char* VV = lds + 65536;
    const int sr = tid >> 4, sc = (tid & 15) * 8;
    bf16x8 kk[4], vv[4]; float gaf[4], gab[4];
#define DC_LOAD(u_) do { const int xc_ = (u_) & 7, w_ = (u_) >> 3, bh_ = xc_ + 8 * (w_ / 32), c_ = w_ % 32, b_ = bh_ / CH, h_ = bh_ % CH; \
        _Pragma("unroll") for (int q = 0; q < 4; ++q) { const int s = q * 32 + sr; const size_t m = (size_t)b_ * T + c_ * LC + s; \
            kk[q] = *(const bf16x8*)(cqk + m * 1536 + 768 + h_ * 128 + sc); vv[q] = *(const bf16x8*)(proj + m * INWP + PC_V + h_ * 128 + sc); \
            gaf[q] = GA[(size_t)(0 * 24 + bh_) * T + c_ * LC + s]; gab[q] = GA[(size_t)(1 * 24 + bh_) * T + c_ * LC + s]; } } while (0)
    if (ufirst < utotal) DC_LOAD(ufirst);
    for (int u = ufirst; u < utotal; u += ustep) {
        const int xc = u & 7, w = u >> 3, bh = xc + 8 * (w / 32), c = w % 32;
        const float mlf = ML[(0 * 24 + bh) * NCH + c], mlb = ML[(1 * 24 + bh) * NCH + c];
#pragma unroll
        for (int q = 0; q < 4; ++q) { const float gwf = ex2((gaf[q] - mlf) * LOG2E), gwb = ex2((gab[q] - mlb) * LOG2E);
            const int off = (q >> 1) * 16384 + v_st((q & 1) * 32 + sr, sc);
            *(LAS bf16x8*)(KF + off) = scale8(kk[q], gwf); *(LAS bf16x8*)(KB + off) = scale8(kk[q], gwb); *(LAS bf16x8*)(VV + off) = vv[q]; }
        __syncthreads();
        if (u + ustep < utotal) DC_LOAD(u + ustep);
        const int dir = wid >> 2, dk0 = wid & 3;
        const int va = lds_addr(dir ? KB : KF) + v_rd_base(lane) + dk0 * 512, vv0 = lds_addr(VV) + v_rd_base(lane);
        f32x16 acc[4], accn;
#pragma unroll
        for (int r = 0; r < 16; ++r) { acc[0][r] = 0.f; acc[1][r] = 0.f; acc[2][r] = 0.f; acc[3][r] = 0.f; accn[r] = 0.f; }
        const bf16x8 ones = {0x3F80, 0x3F80, 0x3F80, 0x3F80, 0x3F80, 0x3F80, 0x3F80, 0x3F80};
#define DC_STEP(t, ks) do { const s16x4 al_ = tr_read<(t) * 16384 + v_rd_off(0, ks, 0)>(va), ah_ = tr_read<(t) * 16384 + v_rd_off(0, ks, 1)>(va); \
        const s16x4 b0l = tr_read<(t) * 16384 + v_rd_off(0, ks, 0)>(vv0), b0h = tr_read<(t) * 16384 + v_rd_off(0, ks, 1)>(vv0), b1l = tr_read<(t) * 16384 + v_rd_off(1, ks, 0)>(vv0), b1h = tr_read<(t) * 16384 + v_rd_off(1, ks, 1)>(vv0); \
        const s16x4 b2l = tr_read<(t) * 16384 + v_rd_off(2, ks, 0)>(vv0), b2h = tr_read<(t) * 16384 + v_rd_off(2, ks, 1)>(vv0), b3l = tr_read<(t) * 16384 + v_rd_off(3, ks, 0)>(vv0), b3h = tr_read<(t) * 16384 + v_rd_off(3, ks, 1)>(vv0); \
        asm volatile("s_waitcnt lgkmcnt(0)" ::: "memory"); SBAR(); const bf16x8 A_ = PK8(al_, ah_); \
        acc[0] = __builtin_amdgcn_mfma_f32_32x32x16_bf16(A_, PK8(b0l, b0h), acc[0], 0, 0, 0); acc[1] = __builtin_amdgcn_mfma_f32_32x32x16_bf16(A_, PK8(b1l, b1h), acc[1], 0, 0, 0); \
        acc[2] = __builtin_amdgcn_mfma_f32_32x32x16_bf16(A_, PK8(b2l, b2h), acc[2], 0, 0, 0); acc[3] = __builtin_amdgcn_mfma_f32_32x32x16_bf16(A_, PK8(b3l, b3h), acc[3], 0, 0, 0); \
        accn = __builtin_amdgcn_mfma_f32_32x32x16_bf16(A_, ones, accn, 0, 0, 0); } while (0)
        DC_STEP(0, 0); DC_STEP(0, 1); DC_STEP(0, 2); DC_STEP(0, 3); DC_STEP(1, 0); DC_STEP(1, 1); DC_STEP(1, 2); DC_STEP(1, 3);
#undef DC_STEP
        bf16* dp = dC + ((size_t)(dir * 24 + bh) * NCH + c) * (LC * HD) + (size_t)(dk0 * 32) * HD + r32;
#pragma unroll
        for (int r = 0; r < 16; ++r)
#pragma unroll
            for (int d = 0; d < 4; ++d) dp[(size_t)crow(r, hi) * HD + d * 32] = (bf16)f2bf(acc[d][r]);
        if (r32 == 0) { float* np = dn + ((size_t)(dir * 24 + bh) * NCH + c) * HD + dk0 * 32;
#pragma unroll
            for (int r = 0; r < 16; ++r) np[crow(r, hi)] = accn[r]; }
        __syncthreads();
    }
#undef DC_LOAD
}

constexpr int SM_OFF = 132096;
__device__ __forceinline__ void mlstm_out_unit(LAS char* lds, const bf16* __restrict__ cqk, const bf16* __restrict__ proj, const float* __restrict__ GA, const float* __restrict__ GM, const float* __restrict__ GB,
                                               const float* __restrict__ MS, const bf16* __restrict__ Cst, const float* __restrict__ nst, bf16* __restrict__ heads, const float* __restrict__ hng, int b, int h, int c, unsigned long long* tsp = nullptr) {
    int tid_ = threadIdx.x; asm volatile("" : "+v"(tid_)); const int tid = tid_, wid = __builtin_amdgcn_readfirstlane(tid >> 6), lane = tid & 63, r32 = lane & 31, hi = lane >> 5;
#if MK_TIME_A >= 130 && MK_TIME_A <= 134
    unsigned long long tprev_ = 0;
#define OUT_TS(i) do { __builtin_amdgcn_s_waitcnt(0); const unsigned long long t_ = __builtin_amdgcn_s_memrealtime(); if ((i) > 0 && threadIdx.x == 0 && blockIdx.x == MK_TIME_BLK) tsp[46 + (i)] += t_ - tprev_; tprev_ = t_; } while (0)
#else
#define OUT_TS(i)
#endif
    OUT_TS(0);
    const int bh = b * CH + h, rg = wid & 3, ch = wid >> 2;
    LAS char* KK = lds; LAS char* VV = lds + 32768; LAS char* CF = lds + 65536; LAS char* CB = lds + 98304;
    LAS float* SM = (LAS float*)(lds + SM_OFF);
    const int sr = tid >> 4, sc = (tid & 15) * 8;
    const size_t m0 = (size_t)b * T + c * LC;
    const size_t seqf = (size_t)(0 * 24 + bh), seqb = (size_t)(1 * 24 + bh);
    const bf16* cfp = Cst + (seqf * NCH + c) * (LC * HD); const bf16* cbp = Cst + (seqb * NCH + c) * (LC * HD);
    const int i = rg * 32 + r32;
    bf16x8 qr[8];
    float msf, msb, gmf, gmb, bcf, bcb;
    {
        bf16x8 tk[4], tv[4], tf[4], tb_[4]; float s0 = 0.f, s1 = 0.f, s2_ = 0.f, s3 = 0.f;
#pragma unroll
        for (int q = 0; q < 4; ++q) { const int s = q * 32 + sr;
            tk[q] = *(const bf16x8*)(cqk + (m0 + s) * 1536 + 768 + h * 128 + sc);
            tv[q] = *(const bf16x8*)(proj + (m0 + s) * INWP + PC_V + h * 128 + sc);
            tf[q] = *(const bf16x8*)(cfp + (size_t)s * HD + sc);
            tb_[q] = *(const bf16x8*)(cbp + (size_t)s * HD + sc); }
        const int t128 = tid & 127;
        if (tid < 128) { s0 = GA[seqf * T + c * LC + t128]; s1 = GA[seqb * T + c * LC + t128]; s2_ = nst[(seqf * NCH + c) * HD + t128]; s3 = nst[(seqb * NCH + c) * HD + t128]; }
        { const bf16* qp = cqk + (m0 + i) * 1536 + h * 128 + hi * 8;
#pragma unroll
          for (int d0 = 0; d0 < 8; ++d0) qr[d0] = *(const bf16x8*)(qp + d0 * 16); }
        msf = MS[seqf * NCH + c]; msb = MS[seqb * NCH + c];
        gmf = GM[seqf * T + c * LC + i]; gmb = GM[seqb * T + c * LC + i]; bcf = GB[seqf * T + c * LC + i]; bcb = GB[seqb * T + c * LC + i];
        asm volatile("" : "+v"(s0), "+v"(s1), "+v"(s2_), "+v"(s3) :: "memory");
#pragma unroll
        for (int q = 0; q < 4; ++q) {
            *(LAS bf16x8*)(KK + (q >> 1) * 16384 + KSWZ((q & 1) * 32 + sr, sc * 2)) = tk[q];
            const int off = (q >> 1) * 16384 + v_st((q & 1) * 32 + sr, sc);
            *(LAS bf16x8*)(VV + off) = tv[q]; *(LAS bf16x8*)(CF + off) = tf[q]; *(LAS bf16x8*)(CB + off) = tb_[q]; }
        if (tid < 128) { SM[tid] = s0 * LOG2E; SM[128 + tid] = s1 * LOG2E; SM[256 + tid] = s2_; SM[384 + tid] = s3; }
    }
    const float Mf = fmaxf(msf, gmf), Mb = fmaxf(msb, gmb);
    __syncthreads();
    OUT_TS(1);
    f32x16 p[2][2];
    qkt<8, true>(p[0][0], p[0][1], KK, qr, 0, r32, hi);
    qkt<8, true>(p[1][0], p[1][1], KK + 16384, qr, 0, r32, hi);
    float qnf = 0.f, qnb = 0.f;
#pragma unroll
    for (int d0 = 0; d0 < 8; ++d0) {
#pragma unroll
        for (int j = 0; j < 8; ++j) { const float qv = bf2f((unsigned short)qr[d0][j]); const int dim = d0 * 16 + hi * 8 + j; qnf = fmaf(qv, SM[256 + dim], qnf); qnb = fmaf(qv, SM[384 + dim], qnb); }
        SBAR(); }
    qnf = xhalf_sum(qnf); qnb = xhalf_sum(qnb);
    const float MfL = Mf * LOG2E, MbL = Mb * LOG2E, tb = (float)(4 * hi - i);
    float rsf = 0.f, rsb = 0.f;
#define OUT_P1(t, hf) do { const int kb_ = 2 * (t) + (hf); \
        if (kb_ < rg) { _Pragma("unroll") for (int r = 0; r < 16; ++r) { const int jc = (t) * 64 + (hf) * 32 + (r & 3) + 8 * (r >> 2); const float e_ = ex2(SM[jc + 4 * hi] - MfL); p[t][hf][r] *= e_; rsf += p[t][hf][r]; } } \
        else if (kb_ > rg) { _Pragma("unroll") for (int r = 0; r < 16; ++r) { const int jc = (t) * 64 + (hf) * 32 + (r & 3) + 8 * (r >> 2); const float e_ = ex2(SM[128 + jc + 4 * hi] - MbL); p[t][hf][r] *= e_; rsb += p[t][hf][r]; } } \
        else { _Pragma("unroll") for (int r = 0; r < 16; ++r) { const int jc = (t) * 64 + (hf) * 32 + (r & 3) + 8 * (r >> 2); const float tt = tb + (float)jc; const LAS float* sj = SM + jc + 4 * hi; \
                const float ef = ex2(fmaf(fmaxf(tt, 0.f), -1e30f, sj[0] - MfL)), eb = ex2(fmaf(fmaxf(-tt, 0.f), -1e30f, sj[128] - MbL)); \
                rsf = fmaf(p[t][hf][r], ef, rsf); rsb = fmaf(p[t][hf][r], eb, rsb); } } \
        SBAR(); } while (0)
    OUT_P1(0, 0); OUT_P1(0, 1); OUT_P1(1, 0); OUT_P1(1, 1);
#undef OUT_P1
    rsf = xhalf_sum(rsf); rsb = xhalf_sum(rsb);
    const float iwf = ex2((msf - Mf) * LOG2E), iwb = ex2((msb - Mb) * LOG2E);
    const float denf = fmaf(iwf, qnf, rsf), denb = fmaf(iwb, qnb, rsb);
    const float rf = __builtin_amdgcn_rcpf(fmaxf(fabsf(denf), ex2((-bcf - Mf) * LOG2E))), rb = __builtin_amdgcn_rcpf(fmaxf(fabsf(denb), ex2((-bcb - Mb) * LOG2E)));
    float tb2 = tb; asm volatile("" : "+v"(tb2));
#define OUT_P2(t, hf) do { const int kb_ = 2 * (t) + (hf); \
        if (kb_ < rg) { _Pragma("unroll") for (int r = 0; r < 16; ++r) p[t][hf][r] *= rf; } \
        else if (kb_ > rg) { _Pragma("unroll") for (int r = 0; r < 16; ++r) p[t][hf][r] *= rb; } \
        else { _Pragma("unroll") for (int r = 0; r < 16; ++r) { const int jc = (t) * 64 + (hf) * 32 + (r & 3) + 8 * (r >> 2); const float tt = tb2 + (float)jc; const LAS float* sj = SM + jc + 4 * hi; \
                const float ef = ex2(fmaf(fmaxf(tt, 0.f), -1e30f, sj[0] - MfL)), eb = ex2(fmaf(fmaxf(-tt, 0.f), -1e30f, sj[128] - MbL)); \
                p[t][hf][r] *= fmaf(ef, rf, eb * rb); } } \
        SBAR(); } while (0)
    OUT_P2(0, 0); OUT_P2(0, 1); OUT_P2(1, 0); OUT_P2(1, 1);
#undef OUT_P2
    const float sf = iwf * rf, sb = iwb * rb;
    OUT_TS(2);
    const int col0 = ch * 64 + r32;
    unsigned short graw[16][2];
#pragma unroll
    for (int r = 0; r < 16; ++r) { const unsigned short* gp = (const unsigned short*)(proj + (m0 + rg * 32 + crow(r, hi)) * INWP + PC_O + h * 128 + col0); graw[r][0] = gp[0]; graw[r][1] = gp[32]; }
    const float g0 = hng[(AH + BH + h) * 128 + col0], g1 = hng[(AH + BH + h) * 128 + col0 + 32];
    asm volatile("" ::: "memory");
    f32x16 o[2];
#pragma unroll
    for (int r = 0; r < 16; ++r) { o[0][r] = 0.f; o[1][r] = 0.f; }
    const int vbv = lds_addr(VV) + v_rd_base(lane) + ch * 1024, vbf = lds_addr(CF) + v_rd_base(lane) + ch * 1024, vbb = lds_addr(CB) + v_rd_base(lane) + ch * 1024;
    {   const bf16x8 a0 = pk4<0>(p[0][0]), a1 = pk4<8>(p[0][0]), a2 = pk4<0>(p[0][1]), a3 = pk4<8>(p[0][1]);
        pv_one<0>(o[0], vbv, a0, a1, a2, a3); pv_one<1>(o[1], vbv, a0, a1, a2, a3); }
    {   const bf16x8 a0 = pk4<0>(p[1][0]), a1 = pk4<8>(p[1][0]), a2 = pk4<0>(p[1][1]), a3 = pk4<8>(p[1][1]);
        pv_one<0>(o[0], vbv + 16384, a0, a1, a2, a3); pv_one<1>(o[1], vbv + 16384, a0, a1, a2, a3); }
    {   const bf16x8 a0 = scale8(qr[0], sf), a1 = scale8(qr[1], sf), a2 = scale8(qr[2], sf), a3 = scale8(qr[3], sf);
        pv_one<0>(o[0], vbf, a0, a1, a2, a3); pv_one<1>(o[1], vbf, a0, a1, a2, a3); }
    {   const bf16x8 a0 = scale8(qr[4], sf), a1 = scale8(qr[5], sf), a2 = scale8(qr[6], sf), a3 = scale8(qr[7], sf);
        pv_one<0>(o[0], vbf + 16384, a0, a1, a2, a3); pv_one<1>(o[1], vbf + 16384, a0, a1, a2, a3); }
    {   const bf16x8 a0 = scale8(qr[0], sb), a1 = scale8(qr[1], sb), a2 = scale8(qr[2], sb), a3 = scale8(qr[3], sb);
        pv_one<0>(o[0], vbb, a0, a1, a2, a3); pv_one<1>(o[1], vbb, a0, a1, a2, a3); }
    {   const bf16x8 a0 = scale8(qr[4], sb), a1 = scale8(qr[5], sb), a2 = scale8(qr[6], sb), a3 = scale8(qr[7], sb);
        pv_one<0>(o[0], vbb + 16384, a0, a1, a2, a3); pv_one<1>(o[1], vbb + 16384, a0, a1, a2, a3); }
    OUT_TS(3);
    float ss[16];
    {
#pragma unroll
        for (int r = 0; r < 16; ++r) { float s2 = 0.f;
#pragma unroll
            for (int d = 0; d < 2; ++d) { const float gate = bf2f(graw[r][d]); const float v = o[d][r] * __builtin_amdgcn_rcpf(1.f + ex2(-gate * LOG2E)); o[d][r] = v; s2 = fmaf(v, v, s2); }
            ss[r] = s2; }
#pragma unroll
        for (int mk = 1; mk < 32; mk <<= 1) {
#pragma unroll
            for (int r = 0; r < 16; ++r) ss[r] += __shfl_xor(ss[r], mk); }
#pragma unroll
        for (int r = 0; r < 16; ++r) if (r32 == 0) SM[512 + ch * 128 + rg * 32 + crow(r, hi)] = ss[r]; }
    __syncthreads();
#pragma unroll
    for (int r = 0; r < 16; ++r) { const float tot = ss[r] + SM[512 + (ch ^ 1) * 128 + rg * 32 + crow(r, hi)]; const float rs = __builtin_amdgcn_rsqf(tot * (1.f / 128.f) + EPS);
        bf16* hp = heads + (m0 + rg * 32 + crow(r, hi)) * DM + (AH + BH + h) * 128 + col0;
        hp[0] = (bf16)f2bf(o[0][r] * rs * g0); hp[32] = (bf16)f2bf(o[1][r] * rs * g1); }
    __syncthreads();
    OUT_TS(4);
#undef OUT_TS
}

constexpr size_t MiB = 1u << 20;
constexpr size_t WS_CTL = 0, CTL_ZERO_BYTES = (MK_TIME_A >= 0 || MK_TIME_B >= 0) ? 1 * MiB : 64 * 1024;
constexpr size_t WS_GATES = 1 * MiB;
constexpr size_t GSEQ_BYTES = (size_t)2 * 24 * T * 4;
constexpr size_t WS_GA = 3 * MiB, WS_GM = WS_GA + GSEQ_BYTES, WS_GB = WS_GM + GSEQ_BYTES;
constexpr size_t WS_MS = WS_GB + GSEQ_BYTES, WS_ML = WS_MS + 8192, WS_BL = WS_ML + 8192, WS_AL = WS_BL + 8192, WS_NRM = WS_AL + 8192;
constexpr size_t WS_DN = 6 * MiB;
constexpr size_t WS_LSE = 7 * MiB;
constexpr size_t WS_MEMB = 9 * MiB;
constexpr size_t WS_KV = 13 * MiB;
constexpr size_t WS_W = 22 * MiB;
constexpr size_t W_IN = 0, W_OUT = 28 * MiB, W_XQ = 36 * MiB, W_XKV = 44 * MiB, W_XO = 60 * MiB, W_UP = 68 * MiB, W_DOWN = 100 * MiB;
constexpr size_t WS_ACT0 = 154 * MiB;
constexpr size_t WS_ACT1 = 218 * MiB;
constexpr size_t WS_PROJ = 282 * MiB;
constexpr size_t WS_XRES = 538 * MiB;
constexpr size_t OUT_OG = 0, OUT_DC = 72 * MiB;
constexpr size_t WS_SSP = 626 * MiB;
constexpr size_t WS_END = 628 * MiB;
static_assert(WS_KV + (size_t)1024 * 4096 * 2 <= WS_W && WS_W + 132 * MiB <= WS_ACT0 && WS_PROJ + (size_t)M * INWP * 2 <= WS_XRES && WS_PROJ + (size_t)M * DFF * 2 <= WS_XRES && WS_XRES + (size_t)M * DM * 2 <= WS_SSP, "d_ws map");
static_assert(OUT_OG + (size_t)3 * M * 768 * 2 <= OUT_DC && OUT_DC + (size_t)2 * 24 * 32 * 128 * 128 * 2 <= (size_t)M * DM * 4 && WS_NRM + 65536 <= WS_DN && WS_LSE + (size_t)3 * M * 6 * 4 <= WS_MEMB, "d_ws map 2");
constexpr int CW_TMO = 0, CW_BAR = 4096;
constexpr int RING_OFF = 0, RING_BYTES = 131072, LDSCTL_OFF = RING_BYTES, MISC_OFF = LDSCTL_OFF + 320, LDS_BYTES = 151552;
constexpr int TBL_OFF = 136192;
constexpr int NWAVES = 8;
constexpr int NPH = 15, NPHT = DEPTH * NPH + 1;

#define XB_TMO      128
#define XB_XCNT(j)  (256  + 64 * (j))
#define XB_XSUB(j)  (1280 + 64 * (j))
#define XB_XGEN(j)  (2304 + 64 * (j))
#define XB_TOP      3328
#define XB_TOPGEN   3392
#define XCD_BAR_WORDS 3456
#define XB_SPIN_CAP (1u << 18)

__device__ __forceinline__ unsigned xb_ld(unsigned* p)              { return __hip_atomic_load(p, __ATOMIC_RELAXED, __HIP_MEMORY_SCOPE_AGENT); }
__device__ __forceinline__ unsigned xb_add(unsigned* p, unsigned v) { return __hip_atomic_fetch_add(p, v, __ATOMIC_RELAXED, __HIP_MEMORY_SCOPE_AGENT); }
__device__ __forceinline__ unsigned xb_xcc_id() { return (unsigned)__builtin_amdgcn_s_getreg((3 << 11) | 20) & 0xFu; }
#define XB_SPIN(cond, bar) do { unsigned _sp = 0; while (cond) { __builtin_amdgcn_s_sleep(1); \
    if ((++_sp & 255u) == 0u) { if (xb_ld(&(bar)[XB_TMO])) break; if (_sp > XB_SPIN_CAP) { atomicAdd(&(bar)[XB_TMO], 1u); break; } } } } while (0)

struct XcdBarrier {
    unsigned* bar; unsigned x;
    volatile LAS unsigned* st;
};

__device__ __forceinline__ XcdBarrier xcd_barrier_post(unsigned* bar, volatile LAS unsigned* st) {
    XcdBarrier b; b.bar = bar; b.x = xb_xcc_id(); b.st = st;
    if (threadIdx.x == 0) (void)xb_add(&bar[XB_XCNT(b.x)], 1u);
    return b;
}
__device__ __forceinline__ void xcd_barrier_complete(unsigned* bar, unsigned x, unsigned& nloc, unsigned& nx) {
    const unsigned G = gridDim.x * gridDim.y * gridDim.z;
    unsigned sum, cnt, mine, sp = 0u;
    for (;;) {
        sum = 0u; cnt = 0u; mine = 0u;
        unsigned cv[16];
        { unsigned* cp = &bar[XB_XCNT(0)];
          asm volatile("global_load_dword %0, %16, off sc1\n\tglobal_load_dword %1, %16, off offset:256 sc1\n\tglobal_load_dword %2, %16, off offset:512 sc1\n\tglobal_load_dword %3, %16, off offset:768 sc1\n\t"
                       "global_load_dword %4, %16, off offset:1024 sc1\n\tglobal_load_dword %5, %16, off offset:1280 sc1\n\tglobal_load_dword %6, %16, off offset:1536 sc1\n\tglobal_load_dword %7, %16, off offset:1792 sc1\n\t"
                       "global_load_dword %8, %16, off offset:2048 sc1\n\tglobal_load_dword %9, %16, off offset:2304 sc1\n\tglobal_load_dword %10, %16, off offset:2560 sc1\n\tglobal_load_dword %11, %16, off offset:2816 sc1\n\t"
                       "global_load_dword %12, %16, off offset:3072 sc1\n\tglobal_load_dword %13, %16, off offset:3328 sc1\n\tglobal_load_dword %14, %16, off offset:3584 sc1\n\tglobal_load_dword %15, %16, off offset:3840 sc1\n\ts_waitcnt vmcnt(0)"
                       : "=&v"(cv[0]), "=&v"(cv[1]), "=&v"(cv[2]), "=&v"(cv[3]), "=&v"(cv[4]), "=&v"(cv[5]), "=&v"(cv[6]), "=&v"(cv[7]), "=&v"(cv[8]), "=&v"(cv[9]), "=&v"(cv[10]), "=&v"(cv[11]), "=&v"(cv[12]), "=&v"(cv[13]), "=&v"(cv[14]), "=&v"(cv[15])
                       : "v"(cp) : "memory"); }
#pragma unroll
        for (unsigned j = 0; j < 16; ++j) { const unsigned c = cv[j]; sum += c; cnt += (c > 0u) ? 1u : 0u; mine = (j == x) ? c : mine; }
        if (sum == G) break;
        __builtin_amdgcn_s_sleep(1);
        if ((++sp & 255u) == 0u) { if (xb_ld(&bar[XB_TMO])) break; if (sp > XB_SPIN_CAP) { atomicAdd(&bar[XB_TMO], 1u); break; } }
    }
    nloc = mine > 0u ? mine : 1u; nx = cnt > 0u ? cnt : 1u;
}

__device__ __forceinline__ void xcd_barrier(const XcdBarrier& b) {
    asm volatile("s_waitcnt vmcnt(0)" ::: "memory");
    __syncthreads();
    if (threadIdx.x == 0) {
        unsigned* bar = b.bar;
        __builtin_amdgcn_s_waitcnt(0);
        unsigned nloc = b.st[0], nx = b.st[1];
        if (nloc == 0u) { xcd_barrier_complete(bar, b.x, nloc, nx); b.st[0] = nloc; b.st[1] = nx; }
        const unsigned old = xb_add(&bar[XB_XSUB(b.x)], 1u);
        const unsigned gen = old / nloc;
        if (old + 1u == (gen + 1u) * nloc) {
            __builtin_amdgcn_fence(__ATOMIC_RELEASE, "agent");
            asm volatile("s_waitcnt vmcnt(0)" ::: "memory");
            const unsigned og = xb_add(&bar[XB_TOP], 1u);
            const unsigned tg = og / nx;
            if (og + 1u == (tg + 1u) * nx) xb_add(&bar[XB_TOPGEN], 1u);
            else XB_SPIN(xb_ld(&bar[XB_TOPGEN]) == tg, bar);
            __builtin_amdgcn_fence(__ATOMIC_ACQUIRE, "agent");
            xb_add(&bar[XB_XGEN(b.x)], 1u);
            asm volatile("s_waitcnt vmcnt(0)" ::: "memory");
        } else {
            XB_SPIN(xb_ld(&bar[XB_XGEN(b.x)]) == gen, bar);
            __builtin_amdgcn_fence(__ATOMIC_ACQUIRE, "agent");
            asm volatile("s_waitcnt vmcnt(0)" ::: "memory");
        }
    }
    __syncthreads();
}

__device__ __forceinline__ float wave_sum(float v) {
#pragma unroll
    for (int o = 1; o < 64; o <<= 1) v += __shfl_xor(v, o);
    return v;
}
__device__ __forceinline__ float wave_incl_sum(float x, int lane) {
#pragma unroll
    for (int o = 1; o < 64; o <<= 1) { const float v = __shfl_up(x, o); if (lane >= o) x += v; }
    return x;
}
__device__ __forceinline__ float wave_incl_max(float x, int lane) {
#pragma unroll
    for (int o = 1; o < 64; o <<= 1) { const float v = __shfl_up(x, o); if (lane >= o) x = fmaxf(x, v); }
    return x;
}
__device__ __forceinline__ void tr_load(float (&v)[32], const float* __restrict__ W, int N, int nblk, int r, int lane) {
    const int r2 = r >> 2, kb = (r2 / nblk) * 4 + (r & 3), nb = r2 % nblk, k0 = 64 * kb, n0 = 32 * nb;
    const int nn = n0 + (lane & 31); const bool ok = nn < N;
    const float* p = W + (size_t)(k0 + (lane >> 5)) * N + (ok ? nn : N - 1);
    const float okf = ok ? 1.f : 0.f;
#pragma unroll
    for (int i = 0; i < 32; ++i) v[i] = p[(size_t)(2 * i) * N] * okf;
}
__device__ __forceinline__ void tr_store(const float (&v)[32], bf16* __restrict__ WT, const LAS float* gain  , int K, int nblk, int r, LAS float* scr, int lane, int cs_lo, int cs_hi, float cs_val, int cs2_hi, float cs2_val) {
    const int r2 = r >> 2, kb = (r2 / nblk) * 4 + (r & 3), nb = r2 % nblk, k0 = 64 * kb, n0 = 32 * nb;
#pragma unroll
    for (int i = 0; i < 32; ++i) scr[(2 * i + (lane >> 5)) * 33 + (lane & 31)] = v[i];
    LDS_WAIT(); asm volatile("" ::: "memory");
    const int c = lane & 7;
    float g[8];
#pragma unroll
    for (int e = 0; e < 8; ++e) g[e] = gain ? gain[k0 + 8 * c + e] : 1.f;
#pragma unroll
    for (int j = 0; j < 4; ++j) { const int n = (lane >> 3) + 8 * j; const LAS float* s = scr + (8 * c) * 33 + n; const float cs = (n0 + n >= cs_lo && n0 + n < cs_hi) ? cs_val : ((n0 + n < cs2_hi) ? cs2_val : 1.f);
        v4u o; o.x = pk2(s[0 * 33] * g[0] * cs, s[1 * 33] * g[1] * cs); o.y = pk2(s[2 * 33] * g[2] * cs, s[3 * 33] * g[3] * cs); o.z = pk2(s[4 * 33] * g[4] * cs, s[5 * 33] * g[5] * cs); o.w = pk2(s[6 * 33] * g[6] * cs, s[7 * 33] * g[7] * cs);
        *(v4u*)(WT + (size_t)(n0 + n) * K + k0 + 8 * c) = o; }
    LDS_WAIT(); asm volatile("" ::: "memory");
}
__device__ __forceinline__ void rownorm_bf16(const float* __restrict__ X, bf16* __restrict__ O, int nrows, int gw, int NGW, int lane) {
    for (int m0 = gw; m0 < nrows; m0 += 2 * NGW) {
        const int m1 = m0 + NGW < nrows ? m0 + NGW : m0;
        const f32x4* xa = (const f32x4*)(X + (size_t)m0 * DM) + lane; const f32x4* xb = (const f32x4*)(X + (size_t)m1 * DM) + lane; f32x4 va[8], vb[8]; float sa = 0.f, sb = 0.f;
#pragma unroll
        for (int j = 0; j < 8; ++j) { va[j] = xa[64 * j]; vb[j] = xb[64 * j]; }
#pragma unroll
        for (int j = 0; j < 8; ++j) { sa += (va[j].x * va[j].x + va[j].y * va[j].y) + (va[j].z * va[j].z + va[j].w * va[j].w); sb += (vb[j].x * vb[j].x + vb[j].y * vb[j].y) + (vb[j].z * vb[j].z + vb[j].w * vb[j].w); }
        const float ra = 1.0f / sqrtf(wave_sum(sa) * (1.f / DM) + EPS), rb = 1.0f / sqrtf(wave_sum(sb) * (1.f / DM) + EPS);
        unsigned long long* oa = (unsigned long long*)(O + (size_t)m0 * DM) + lane; unsigned long long* ob = (unsigned long long*)(O + (size_t)m1 * DM) + lane;
#pragma unroll
        for (int j = 0; j < 8; ++j) oa[64 * j] = (unsigned long long)pk2(va[j].x * ra, va[j].y * ra) | ((unsigned long long)pk2(va[j].z * ra, va[j].w * ra) << 32);
        if (m1 != m0) {
#pragma unroll
            for (int j = 0; j < 8; ++j) ob[64 * j] = (unsigned long long)pk2(vb[j].x * rb, vb[j].y * rb) | ((unsigned long long)pk2(vb[j].z * rb, vb[j].w * rb) << 32); }
    }
}
__device__ __forceinline__ void stream_init(const float* __restrict__ X, bf16* __restrict__ O, float* __restrict__ ssp, int nrows, int gw, int NGW, int lane) {
    for (int m0 = gw; m0 < nrows; m0 += 2 * NGW) {
        const int m1 = m0 + NGW < nrows ? m0 + NGW : m0;
        const f32x4* xa = (const f32x4*)(X + (size_t)m0 * DM) + lane; const f32x4* xb = (const f32x4*)(X + (size_t)m1 * DM) + lane; f32x4 va[8], vb[8]; float sa = 0.f, sb = 0.f;
#pragma unroll
        for (int j = 0; j < 8; ++j) { va[j] = xa[64 * j]; vb[j] = xb[64 * j]; }
#pragma unroll
        for (int j = 0; j < 8; ++j) { sa += (va[j].x * va[j].x + va[j].y * va[j].y) + (va[j].z * va[j].z + va[j].w * va[j].w); sb += (vb[j].x * vb[j].x + vb[j].y * vb[j].y) + (vb[j].z * vb[j].z + vb[j].w * vb[j].w); }
        sa = wave_sum(sa); sb = wave_sum(sb);
        unsigned long long* oa = (unsigned long long*)(O + (size_t)m0 * DM) + lane; unsigned long long* ob = (unsigned long long*)(O + (size_t)m1 * DM) + lane;
#pragma unroll
        for (int j = 0; j < 8; ++j) oa[64 * j] = (unsigned long long)pk2(va[j].x, va[j].y) | ((unsigned long long)pk2(va[j].z, va[j].w) << 32);
        if (lane < 32) ssp[(size_t)m0 * 32 + lane] = lane == 0 ? sa : 0.f;
        if (m1 != m0) {
#pragma unroll
            for (int j = 0; j < 8; ++j) ob[64 * j] = (unsigned long long)pk2(vb[j].x, vb[j].y) | ((unsigned long long)pk2(vb[j].z, vb[j].w) << 32);
            if (lane < 32) ssp[(size_t)m1 * 32 + lane] = lane == 0 ? sb : 0.f; }
    }
}
__device__ __forceinline__ float log_sigmoid(float x) { return fminf(x, 0.f) - log1pf(expf(-fabsf(x))); }

__device__ __forceinline__ void build_rtab(const pg8::StaticOrder& S, const float* __restrict__ ssp, LAS float* rt) {
    int tid_ = threadIdx.x; asm volatile("" : "+v"(tid_)); const int rl = tid_ & 255;
#pragma unroll 1
    for (int i = tid_ >> 8; i < 8; i += 2) { pg8::Unit u; u.pm = 0; u.pn = 0; const bool ok = S.next(i, u); if (!ok) break;
        const f32x4* pp = (const f32x4*)(ssp + (size_t)(u.pm * 256 + rl) * 32); float t = 0.f;
#pragma unroll
        for (int q = 0; q < 8; ++q) { const f32x4 a = pp[q]; t += (a[0] + a[1]) + (a[2] + a[3]); }
        rt[i * 256 + rl] = 1.0f / sqrtf(t * (1.f / DM) + EPS); }
    __syncthreads();
}
struct Args { const float* in[18]; float* out; unsigned char* ws; int ph_lo, ph_hi; };

#ifndef PG8_SP2
#define PG8_SP2 true
#endif
#ifndef PG8_ALIGN
#define PG8_ALIGN true
#endif

__global__ void __launch_bounds__(NWAVES * 64, 2) enc_fwd(Args args) {
    extern __shared__ __attribute__((aligned(16))) unsigned char lds_raw[];
    LAS unsigned char* lds = (LAS unsigned char*)lds_raw;
    volatile LAS unsigned* MISC = (volatile LAS unsigned*)(lds + MISC_OFF);
    const int G = gridDim.x, bx = blockIdx.x;
    const int vcu = (G % 8 == 0) ? (bx % 8) * (G / 8) + bx / 8 : bx;
    const int NGW = G * NWAVES; const size_t NTH = (size_t)G * NWAVES * 64;
#define PH_IDS int ptid_ = threadIdx.x; asm volatile("" : "+v"(ptid_)); const int tid = ptid_, lane = tid & 63, wave = __builtin_amdgcn_readfirstlane(tid >> 6); \
    const int gw = vcu * NWAVES + wave; const size_t gt = (size_t)bx * (NWAVES * 64) + tid; (void)lane; (void)gw; (void)gt;
    unsigned char* ws = args.ws;
    gu32* ctl = (gu32*)(ws + WS_CTL);
    for (int u = threadIdx.x; u < (LDS_BYTES - LDSCTL_OFF) / 4; u += NWAVES * 64) ((LAS unsigned*)(lds + LDSCTL_OFF))[u] = 0u;
    __syncthreads();
    XcdBarrier bar = xcd_barrier_post((unsigned*)(ctl + CW_BAR), MISC + 8);
    const int lo = args.ph_lo, hi_ = args.ph_hi;
#define IN(k) (lo <= (k) && (k) < hi_)
#define BUILD_RTAB(S_) build_rtab(S_, SSP, (LAS float*)(lds + 132096))
#define REPS(k) for (int rep_ = 0; rep_ < (((k) == MK_REP_PHASE) ? MK_REP_N + 1 : 1); ++rep_)
#if MK_TIME_A >= 0 || MK_TIME_B >= 0
    unsigned long long* TS = (unsigned long long*)(ws + WS_CTL + 524288);
    if (bx == 0 && threadIdx.x == 0) TS[63] = __builtin_amdgcn_s_memrealtime();
#define SEAM(k) do { if (IN(k) && IN((k) + 1)) xcd_barrier(bar); if (bx == 0 && threadIdx.x == 0) TS[k] = __builtin_amdgcn_s_memrealtime(); } while (0)
#else
#define SEAM(k) do { if (IN(k) && IN((k) + 1)) xcd_barrier(bar); } while (0)
#endif

    const float* x = args.in[0]; const float* mem = args.in[1]; float* out = args.out;
    float* GATES = (float*)(ws + WS_GATES); float* GA = (float*)(ws + WS_GA); float* GM = (float*)(ws + WS_GM); float* GB = (float*)(ws + WS_GB);
    float* MSa = (float*)(ws + WS_MS); float* MLa = (float*)(ws + WS_ML); float* BLa = (float*)(ws + WS_BL); float* ALa = (float*)(ws + WS_AL); float* NRM = (float*)(ws + WS_NRM); float* SSP = (float*)(ws + WS_SSP); float* DN = (float*)(ws + WS_DN); float* LSE = (float*)(ws + WS_LSE);
    bf16* MEMB = (bf16*)(ws + WS_MEMB); bf16* KV = (bf16*)(ws + WS_KV);
    bf16* Win_t = (bf16*)(ws + WS_W + W_IN); bf16* Wout_t = (bf16*)(ws + WS_W + W_OUT); bf16* Wxq_t = (bf16*)(ws + WS_W + W_XQ); bf16* Wxkv_t = (bf16*)(ws + WS_W + W_XKV);
    bf16* Wxo_t = (bf16*)(ws + WS_W + W_XO); bf16* Wup_t = (bf16*)(ws + WS_W + W_UP); bf16* Wdown_t = (bf16*)(ws + WS_W + W_DOWN);
    bf16* ACT0 = (bf16*)(ws + WS_ACT0); bf16* ACT1 = (bf16*)(ws + WS_ACT1); bf16* CQK = ACT1; bf16* PROJ = (bf16*)(ws + WS_PROJ); bf16* HID = PROJ;
    bf16* OG = (bf16*)((unsigned char*)out + OUT_OG); bf16* DC = (bf16*)((unsigned char*)out + OUT_DC); bf16* XRES = (bf16*)(ws + WS_XRES);

    for (int layer = 0; layer < DEPTH; ++layer) {
        const int pb = layer * NPH;
        const float* norm_mix_g = args.in[2] + (size_t)layer * DM;
        const float* w_in = args.in[3] + (size_t)layer * DM * INW;
        const float* conv_w = args.in[4] + (size_t)layer * 3 * 1536;
        const float* gate_b = args.in[5] + (size_t)layer * 24;
        const float* diff_lambda = args.in[6] + (size_t)layer * 256;
        const float* head_norm_g = args.in[7] + (size_t)layer * DM;
        const float* w_out = args.in[8] + (size_t)layer * DM * DM;
        const float* norm_x_g = args.in[9] + (size_t)layer * DM;
        const float* norm_mem_g = args.in[10] + (size_t)layer * DM;
        const float* w_xq = args.in[11] + (size_t)layer * DM * DM;
        const float* w_xkv = args.in[12] + (size_t)layer * DM * 2 * DM;
        const float* w_xo = args.in[13] + (size_t)layer * DM * DM;
        const float* norm_mlp_g = args.in[14] + (size_t)layer * DM;
        const float* w_up = args.in[15] + (size_t)layer * DM * DFF;
        const float* w_down = args.in[16] + (size_t)layer * DFF * DM;

        REPS(0) if (IN(pb + 0)) { PH_IDS
            LAS float* scr = (LAS float*)(lds + RING_OFF + wave * 8448);
            LAS float* GT = (LAS float*)(lds + RING_OFF + 8 * 8448);
            for (int i = tid; i < 4 * DM; i += NWAVES * 64) { const int j = i >> 11, k = i & (DM - 1); GT[i] = (j == 0 ? norm_mix_g : (j == 1 ? norm_x_g : (j == 2 ? norm_mem_g : norm_mlp_g)))[k]; }
            __syncthreads();
            constexpr int I_IN = (DM / 64) * (INWP / 32), I_SQ = (DM / 64) * (DM / 32), I_KV = (DM / 64) * (2 * DM / 32), I_UP = (DM / 64) * (DFF / 32), I_DN = (DFF / 64) * (DM / 32);
            constexpr int NITEMS = I_IN + 3 * I_SQ + I_KV + I_UP + I_DN;
#define TR_DECODE(P, it_) int P##r = (it_); const float* P##W; bf16* P##T; const LAS float* P##g; int P##K, P##N, P##nb, P##lo = 0, P##hi = 0, P##h2 = 0; \
                if (P##r < I_IN) { P##W = w_in; P##T = Win_t; P##g = GT; P##K = DM; P##N = INW; P##nb = INWP / 32; P##lo = PB_Q; P##hi = PB_K; P##h2 = PA_K; } \
                else if ((P##r -= I_IN) < I_SQ) { P##W = w_out; P##T = Wout_t; P##g = nullptr; P##K = DM; P##N = DM; P##nb = DM / 32; } \
                else if ((P##r -= I_SQ) < I_SQ) { P##W = w_xq; P##T = Wxq_t; P##g = GT + 2048; P##K = DM; P##N = DM; P##nb = DM / 32; } \
                else if ((P##r -= I_SQ) < I_KV) { P##W = w_xkv; P##T = Wxkv_t; P##g = GT + 4096; P##K = DM; P##N = 2 * DM; P##nb = 2 * DM / 32; } \
                else if ((P##r -= I_KV) < I_SQ) { P##W = w_xo; P##T = Wxo_t; P##g = nullptr; P##K = DM; P##N = DM; P##nb = DM / 32; } \
                else if ((P##r -= I_SQ) < I_UP) { P##W = w_up; P##T = Wup_t; P##g = GT + 6144; P##K = DM; P##N = DFF; P##nb = DFF / 32; } \
                else { P##r -= I_UP; P##W = w_down; P##T = Wdown_t; P##g = nullptr; P##K = DFF; P##N = DM; P##nb = DM / 32; }
            for (int it = 6 * gw; it < NITEMS; it += 6 * NGW) {
                float va[32], vb[32], vc[32], vd[32], ve[32], vf[32];
                TR_DECODE(a_, (it + 0 < NITEMS) ? it + 0 : it) TR_DECODE(b_, (it + 1 < NITEMS) ? it + 1 : it) TR_DECODE(c_, (it + 2 < NITEMS) ? it + 2 : it) TR_DECODE(d_, (it + 3 < NITEMS) ? it + 3 : it) TR_DECODE(e_, (it + 4 < NITEMS) ? it + 4 : it) TR_DECODE(f_, (it + 5 < NITEMS) ? it + 5 : it)
                tr_load(va, a_W, a_N, a_nb, a_r, lane);
                tr_load(vb, b_W, b_N, b_nb, b_r, lane);
                tr_load(vc, c_W, c_N, c_nb, c_r, lane);
                tr_load(vd, d_W, d_N, d_nb, d_r, lane);
                tr_load(ve, e_W, e_N, e_nb, e_r, lane);
                tr_load(vf, f_W, f_N, f_nb, f_r, lane);
                if (it + 0 < NITEMS) tr_store(va, a_T, a_g, a_K, a_nb, a_r, scr, lane, a_lo, a_hi, 0.125f * LOG2E, a_h2, 0.08838834764831845f * LOG2E);
                if (it + 1 < NITEMS) tr_store(vb, b_T, b_g, b_K, b_nb, b_r, scr, lane, b_lo, b_hi, 0.125f * LOG2E, b_h2, 0.08838834764831845f * LOG2E);
                if (it + 2 < NITEMS) tr_store(vc, c_T, c_g, c_K, c_nb, c_r, scr, lane, c_lo, c_hi, 0.125f * LOG2E, c_h2, 0.08838834764831845f * LOG2E);
                if (it + 3 < NITEMS) tr_store(vd, d_T, d_g, d_K, d_nb, d_r, scr, lane, d_lo, d_hi, 0.125f * LOG2E, d_h2, 0.08838834764831845f * LOG2E);
                if (it + 4 < NITEMS) tr_store(ve, e_T, e_g, e_K, e_nb, e_r, scr, lane, e_lo, e_hi, 0.125f * LOG2E, e_h2, 0.08838834764831845f * LOG2E);
                if (it + 5 < NITEMS) tr_store(vf, f_T, f_g, f_K, f_nb, f_r, scr, lane, f_lo, f_hi, 0.125f * LOG2E, f_h2, 0.08838834764831845f * LOG2E);
            }
#undef TR_DECODE
            rownorm_bf16(mem, MEMB, NBATCH * MEML, gw, NGW, lane);
            if (layer == 0) stream_init(x, XRES, SSP, M, gw, NGW, lane);
            __syncthreads();
        }
        SEAM(pb + 0);
        REPS(2) if (IN(pb + 2)) {
            pg8::Gemm g{XRES, Win_t, M, INWP, DM}; pg8::StaticOrder S; S.init(M, INWP, G, bx);
            BUILD_RTAB(S);
            pg8::EpiBf16<0, true> E{PROJ, INWP, 1.f, GATES, PC_G, (const LAS float*)(lds + 132096)};
            pg8::gemm_phase<pg8::EpiBf16<0, true>, pg8::StaticOrder, PG8_ALIGN, PG8_SP2>(lds + RING_OFF, g, S, E);
        }
        SEAM(pb + 2);
        REPS(3) if (IN(pb + 3)) { PH_IDS
#if (MK_SKIP & 7)
            for (size_t i = gt; i < (size_t)M * DM / 8; i += NTH) ((v4u*)ACT0)[i] = (v4u){0u, 0u, 0u, 0u};
#endif
            for (size_t it0 = gt; it0 < (size_t)M * 192; it0 += 4 * NTH) {
                bf16x8 u0[4], u1[4], u2[4]; size_t mm[4]; int cc[4]; bool ok[4];
#pragma unroll
                for (int k = 0; k < 4; ++k) { const size_t it = it0 + k * NTH; ok[k] = it < (size_t)M * 192; const size_t itc = ok[k] ? it : it0;
                    const size_t m = itc / 192; const int c8 = (int)(itc % 192) * 8; const int t = (int)(m % T); mm[k] = m; cc[k] = c8;
                    const bf16* up = PROJ + m * INWP + PC_QK + c8;
                    u1[k] = *(const bf16x8*)up; u0[k] = (bf16x8){0, 0, 0, 0, 0, 0, 0, 0}; u2[k] = (bf16x8){0, 0, 0, 0, 0, 0, 0, 0};
                    if (t > 0) u0[k] = *(const bf16x8*)(up - INWP);
                    if (t < T - 1) u2[k] = *(const bf16x8*)(up + INWP); }
                asm volatile("" ::: "memory");
#pragma unroll
                for (int k = 0; k < 4; ++k) { const int c8 = cc[k]; float y[8];
#pragma unroll
                    for (int e = 0; e < 8; ++e) { const float xx = conv_w[c8 + e] * bf2f((unsigned short)u0[k][e]) + conv_w[1536 + c8 + e] * bf2f((unsigned short)u1[k][e]) + conv_w[3072 + c8 + e] * bf2f((unsigned short)u2[k][e]);
                        float s = xx * __builtin_amdgcn_rcpf(1.f + ex2(-xx * LOG2E)); if (c8 < 768) s *= 0.08838834764831845f; y[e] = s; }
                    if (ok[k]) *(bf16x8*)(CQK + mm[k] * 1536 + c8) = pack8(y); }
            }
            {   LAS unsigned* NM = (LAS unsigned*)(lds + RING_OFF);
                if (tid < 64) NM[tid] = 0u;
                __syncthreads();
                for (size_t it0 = gt; it0 < (size_t)M * 128; it0 += 4 * NTH) { bf16x8 uu[4]; bool ok[4];
#pragma unroll
                    for (int k = 0; k < 4; ++k) { const size_t it = it0 + k * NTH; ok[k] = it < (size_t)M * 128; const size_t itc = ok[k] ? it : it0; uu[k] = *(const bf16x8*)(PROJ + (itc >> 7) * INWP + PB_Q + (int)(itc & 127) * 8); }
#pragma unroll
                    for (int k = 0; k < 4; ++k) { const size_t it = it0 + k * NTH; const size_t m = it >> 7; const int rem = (int)(it & 127); float s = 0.f;
#pragma unroll
                        for (int e = 0; e < 8; ++e) { const float v = bf2f((unsigned short)uu[k][e]); s = fmaf(v, v, s); }
                        s += __shfl_xor(s, 1); s += __shfl_xor(s, 2); s += __shfl_xor(s, 4);
                        if (ok[k] && (lane & 7) == 0) atomicMax((unsigned*)(NM + (int)(m / T) * 16 + (rem >> 3)), __float_as_uint(s)); } }
                __syncthreads();
                if (tid < 64) NRM[(size_t)bx * 64 + tid] = __uint_as_float(NM[tid]);
            }
            for (int task = gw; task < 48 * NCH; task += NGW) {
                const int seq = task / NCH, c = task % NCH, dir = seq / 24, bh = seq % 24, b = bh / CH, h = bh % CH;
                const float bi = gate_b[(dir ? 2 : 0) * CH + h], bf_ = gate_b[(dir ? 3 : 1) * CH + h];
                const int i0 = 2 * lane, i1 = 2 * lane + 1;
                const int t0 = c * LC + (dir ? LC - 1 - i0 : i0), t1 = c * LC + (dir ? LC - 1 - i1 : i1);
                const float* g0 = GATES + ((size_t)b * T + t0) * 24; const float* g1 = GATES + ((size_t)b * T + t1) * 24;
                const float li0 = g0[(dir ? 2 : 0) * CH + h] + bi, li1 = g1[(dir ? 2 : 0) * CH + h] + bi;
                const float lf0 = log_sigmoid(g0[(dir ? 3 : 1) * CH + h] + bf_), lf1 = log_sigmoid(g1[(dir ? 3 : 1) * CH + h] + bf_);
                const float incl = wave_incl_sum(lf0 + lf1, lane);
                const float bc1 = incl, bc0 = incl - lf1;
                const float a0 = li0 - bc0, a1 = li1 - bc1;
                const float imx = wave_incl_max(fmaxf(a0, a1), lane);
                float emx = __shfl_up(imx, 1); if (lane == 0) emx = -INFINITY;
                const size_t sq = (size_t)seq * T;
                GA[sq + t0] = a0; GA[sq + t1] = a1; GM[sq + t0] = fmaxf(emx, a0); GM[sq + t1] = imx; GB[sq + t0] = bc0; GB[sq + t1] = bc1;
                if (lane == 63) { BLa[seq * NCH + c] = bc1; ALa[seq * NCH + c] = imx; }
            }
        }
        SEAM(pb + 3);
        REPS(4) if (IN(pb + 4)) {
            LAS float* TMS = (LAS float*)(lds + TBL_OFF); LAS float* TML = TMS + 48 * NCH;
            {   PH_IDS
                LAS float* SAL = (LAS float*)(lds + RING_OFF); LAS float* SBL = SAL + 48 * NCH;
                for (int i = tid; i < 48 * NCH; i += NWAVES * 64) { SAL[i] = ALa[i]; SBL[i] = BLa[i]; }
                __syncthreads();
                if (tid < 48) { const int seq = tid, dir = seq / 24; float ms = 0.f;
                    for (int p = 0; p < NCH; ++p) { const int c = dir ? NCH - 1 - p : p; const float ml = fmaxf(ms, SAL[seq * NCH + c]);
                        TMS[seq * NCH + c] = ms; TML[seq * NCH + c] = ml; if (bx == 0) { MSa[seq * NCH + c] = ms; MLa[seq * NCH + c] = ml; }
                        ms = SBL[seq * NCH + c] + ml; } }
                __syncthreads(); }
#if !(MK_SKIP & 1)
            REPS(40) for (int u = bx; u < 1152; u += G) { const int xc = u & 7, w = u >> 3, bh = xc + 8 * (w / 48), rem = w % 48, cfg = rem / 16, i16 = rem % 16;
                const int rho = cfg == 0 ? 0 : (cfg == 1 ? (i16 >> 2) : i16), seg = cfg == 0 ? i16 : (cfg == 1 ? (i16 & 3) : 0);
                dilattn_unit((LAS char*)lds, PROJ, OG, LSE, bh / AH, bh % AH, cfg, rho, seg, (MK_REP_PHASE == 40 && rep_ < MK_REP_N) ? MK_A_MODE : 0); }
#endif
#if MK_TIME_A >= 0
            if (bx == MK_TIME_BLK && threadIdx.x == 0) TS[34 + layer] = __builtin_amdgcn_s_memrealtime();
#endif
#if !(MK_SKIP & 4)
            REPS(41) { const bool few_ = (G == 256) && bx < 128;
                mlstm_dc_units((LAS char*)lds, CQK, PROJ, GA, TML, DC, DN, G == 256 ? (few_ ? bx : bx + 128) : bx, G == 256 ? 128 : G, few_ ? 256 : 768); }
#endif
        }
        SEAM(pb + 4);
        REPS(5) if (IN(pb + 5)) { PH_IDS
            const bool split_ = G > 128, kvblk = split_ && bx < 64;
            if (kvblk || !split_) {
                pg8::Gemm g{MEMB, Wxkv_t, NBATCH * MEML, 2 * DM, DM}; pg8::StaticOrder S; S.init(NBATCH * MEML, 2 * DM, G, bx);
                pg8::EpiBf16<0, false> E{KV, 2 * DM, 1.f, nullptr, 0, (const LAS float*)nullptr};
                pg8::gemm_phase<pg8::EpiBf16<0, false>, pg8::StaticOrder, PG8_ALIGN, PG8_SP2>(lds + RING_OFF, g, S, E);
            }
            if (!kvblk) {
            const size_t gtT = split_ ? (size_t)(bx - 64) * (NWAVES * 64) + tid : gt, NTHT = split_ ? (size_t)(G - 64) * NWAVES * 64 : NTH;
#if !(MK_SKIP & 4)
            for (size_t g2 = gtT; g2 < (size_t)48 * 2048; g2 += NTHT) { const int sq = (int)(g2 / 2048), e8 = (int)(g2 % 2048) * 8, dir = sq / 24;
                float S[8];
#pragma unroll
                for (int e = 0; e < 8; ++e) S[e] = 0.f;
                for (int p0 = 0; p0 < NCH; p0 += 8) {
                    bf16x8 xv[8]; float dms[8], dml[8];
#pragma unroll
                    for (int q = 0; q < 8; ++q) { const int c = dir ? NCH - 1 - (p0 + q) : p0 + q;
                        xv[q] = *(const bf16x8*)(DC + ((size_t)sq * NCH + c) * (LC * HD) + e8); dms[q] = MSa[sq * NCH + c]; dml[q] = MLa[sq * NCH + c]; }
                    asm volatile("" : "+v"(dms[0]), "+v"(dms[1]), "+v"(dms[2]), "+v"(dms[3]), "+v"(dms[4]), "+v"(dms[5]), "+v"(dms[6]), "+v"(dms[7]) :: "memory");
#pragma unroll
                    for (int q = 0; q < 8; ++q) { const int c = dir ? NCH - 1 - (p0 + q) : p0 + q; const float dc = expf(dms[q] - dml[q]);
                        *(bf16x8*)(DC + ((size_t)sq * NCH + c) * (LC * HD) + e8) = pack8(S);
#pragma unroll
                        for (int e = 0; e < 8; ++e) S[e] = fmaf(dc, S[e], bf2f((unsigned short)xv[q][e])); }
                }
            }
            for (size_t g2 = gtT; g2 < (size_t)48 * 128; g2 += NTHT) { const int sq = (int)(g2 / 128), d = (int)(g2 % 128), dir = sq / 24; float S = 0.f;
                for (int p0 = 0; p0 < NCH; p0 += 8) { float xv[8], dms[8], dml[8];
#pragma unroll
                    for (int q = 0; q < 8; ++q) { const int c = dir ? NCH - 1 - (p0 + q) : p0 + q; xv[q] = DN[((size_t)sq * NCH + c) * HD + d]; dms[q] = MSa[sq * NCH + c]; dml[q] = MLa[sq * NCH + c]; }
                    asm volatile("" : "+v"(dms[0]), "+v"(dms[1]), "+v"(dms[2]), "+v"(dms[3]), "+v"(dms[4]), "+v"(dms[5]), "+v"(dms[6]), "+v"(dms[7]) :: "memory");
#pragma unroll
                    for (int q = 0; q < 8; ++q) { const int c = dir ? NCH - 1 - (p0 + q) : p0 + q; DN[((size_t)sq * NCH + c) * HD + d] = S; S = fmaf(expf(dms[q] - dml[q]), S, xv[q]); }
                }
            }
#endif
#if !(MK_SKIP & 1)
            for (size_t it0 = gtT; it0 < (size_t)M * AH * 16; it0 += 4 * NTHT) {
                float lv[4][3]; bf16x8 ov[4][3]; f32x4 hg[4][2]; size_t mm[4]; int hh[4], cc[4]; bool ok[4];
#pragma unroll
                for (int k = 0; k < 4; ++k) { const size_t it = it0 + k * NTHT; ok[k] = it < (size_t)M * AH * 16; const size_t itc = ok[k] ? it : it0;
                    const size_t m = itc / (AH * 16); const int rem = (int)(itc % (AH * 16)), h = rem >> 4, c8 = (rem & 15) * 8; mm[k] = m; hh[k] = h; cc[k] = c8;
#pragma unroll
                    for (int g = 0; g < 3; ++g) { lv[k][g] = LSE[(g * (size_t)M + m) * AH + h]; ov[k][g] = *(const bf16x8*)(OG + (g * (size_t)M + m) * 768 + h * 128 + c8); }
                    hg[k][0] = *(const f32x4*)(head_norm_g + h * 128 + c8); hg[k][1] = *(const f32x4*)(head_norm_g + h * 128 + c8 + 4); }
                asm volatile("" ::: "memory");
                float yy[4][8], ssk[4];
#pragma unroll
                for (int k = 0; k < 4; ++k) {
                    const float mx = fmaxf(lv[k][0], fmaxf(lv[k][1], lv[k][2])); float w0 = expf(lv[k][0] - mx), w1 = expf(lv[k][1] - mx), w2 = expf(lv[k][2] - mx); const float inv = 1.f / (w0 + w1 + w2); w0 *= inv; w1 *= inv; w2 *= inv;
                    float ss = 0.f;
#pragma unroll
                    for (int e = 0; e < 8; ++e) { yy[k][e] = w0 * bf2f((unsigned short)ov[k][0][e]) + w1 * bf2f((unsigned short)ov[k][1][e]) + w2 * bf2f((unsigned short)ov[k][2][e]); ss = fmaf(yy[k][e], yy[k][e], ss); }
                    ssk[k] = ss; }
#pragma unroll
                for (int mk = 1; mk < 16; mk <<= 1) {
#pragma unroll
                    for (int k = 0; k < 4; ++k) ssk[k] += __shfl_xor(ssk[k], mk); }
#pragma unroll
                for (int k = 0; k < 4; ++k) { const int h = hh[k], c8 = cc[k];
                    const float rs = __builtin_amdgcn_rsqf(ssk[k] * (1.f / 128.f) + EPS);
                    float y[8];
#pragma unroll
                    for (int e = 0; e < 8; ++e) y[e] = yy[k][e] * rs * hg[k][e >> 2][e & 3];
                    if (ok[k]) *(bf16x8*)(ACT0 + mm[k] * DM + h * 128 + c8) = pack8(y); }
            }
#endif
            }
        }
        SEAM(pb + 5);
        REPS(6) if (IN(pb + 6)) { PH_IDS
#if !(MK_SKIP & 2)
            {
                LAS int* qslot = (LAS int*)(lds + 140000);
                gu32* qctr = ctl + 8192 + 64 * layer;
                if (wave == 0) { const float* dl = diff_lambda;
                    const float s1 = wave_sum(dl[lane] * dl[64 + lane]), s2 = wave_sum(dl[128 + lane] * dl[192 + lane]);
                    const float lam_init = 0.8f - 0.6f * expf(-0.3f * (float)layer);
                    if (lane == 0) { ((LAS float*)qslot)[1] = expf(s1) - expf(s2) + lam_init; ((LAS float*)qslot)[2] = 1.f - lam_init; } }
                for (;;) {
                    __syncthreads();
                    if (threadIdx.x == 0) qslot[0] = (int)__hip_atomic_fetch_add(qctr, 1u, RLX_AGENT);
                    __syncthreads();
                    const int cur = __builtin_amdgcn_readfirstlane(qslot[0]);
                    if (cur >= 512 + 768) break;
#if MK_TIME_A >= 0
                    if (threadIdx.x == 0) ((LAS unsigned long long*)(lds + 140032))[0] = __builtin_amdgcn_s_memrealtime();
#endif
                    if (cur < 512) { const int h = 3 - (cur >> 7), r = cur & 127, qbi = r >> 2, qb = (qbi & 1) ? 15 - (qbi >> 1) : 16 + (qbi >> 1);
                        diffattn_unit((LAS char*)lds, PROJ, ACT0, head_norm_g, (const LAS float*)qslot, NRM, G, r & 3, h, qb); }
                    else { for (int k = 0; k < 1; ++k) { const int u = (cur - 512) + k, xc = u & 7, w = u >> 3, bh = xc + 8 * (w / 32), c = w % 32;
                            #if MK_TIME_A >= 130 && MK_TIME_A <= 134
                            mlstm_out_unit((LAS char*)lds, CQK, PROJ, GA, GM, GB, MSa, DC, DN, ACT0, head_norm_g, bh / CH, bh % CH, c, TS); } }
#else
                            mlstm_out_unit((LAS char*)lds, CQK, PROJ, GA, GM, GB, MSa, DC, DN, ACT0, head_norm_g, bh / CH, bh % CH, c); } }
#endif
#if MK_TIME_A >= 0
                    if (threadIdx.x == 0 && bx == MK_TIME_BLK) { const unsigned long long d_ = __builtin_amdgcn_s_memrealtime() - ((LAS unsigned long long*)(lds + 140032))[0]; TS[36 + (cur < 512 ? 0 : 2) + layer] += d_; }
#endif
                }
            }
#endif
        }
        SEAM(pb + 6);
        REPS(7) if (IN(pb + 7)) {
            pg8::Gemm g{ACT0, Wout_t, M, DM, DM}; pg8::StaticOrder S; S.init(M, DM, G, bx);
            pg8::EpiResBf16<false> E{XRES, XRES, SSP};
            pg8::gemm_phase<pg8::EpiResBf16<false>, pg8::StaticOrder, PG8_ALIGN, PG8_SP2>(lds + RING_OFF, g, S, E);
        }
        SEAM(pb + 7);
        REPS(9) if (IN(pb + 9)) {
            pg8::Gemm g{XRES, Wxq_t, M, DM, DM}; pg8::StaticOrder S; S.init(M, DM, G, bx);
                        BUILD_RTAB(S);
            pg8::EpiBf16<0, false> E{ACT0, DM, 0.044194173824159216f * LOG2E, nullptr, 0, (const LAS float*)(lds + 132096)};
            pg8::gemm_phase<pg8::EpiBf16<0, false>, pg8::StaticOrder, PG8_ALIGN, PG8_SP2>(lds + RING_OFF, g, S, E);
        }
        SEAM(pb + 9);
        REPS(10) if (IN(pb + 10)) {
            for (int u = bx; u < 256; u += G) { const int xc = u & 7, w = u >> 3, bh = xc + 8 * (w / 16), qb = w % 16;
                xattn_unit((LAS char*)lds, ACT0, KV, ACT1, bh / XH, bh % XH, qb); }
        }
        SEAM(pb + 10);
        REPS(11) if (IN(pb + 11)) {
            pg8::Gemm g{ACT1, Wxo_t, M, DM, DM}; pg8::StaticOrder S; S.init(M, DM, G, bx);
            pg8::EpiResBf16<false> E{XRES, (MK_REP_PHASE == 11 && rep_ < MK_REP_N) ? ACT0 : XRES, SSP};
            pg8::gemm_phase<pg8::EpiResBf16<false>, pg8::StaticOrder, PG8_ALIGN, PG8_SP2>(lds + RING_OFF, g, S, E);
        }
        SEAM(pb + 11);
        for (int hf = 0; hf < 2; ++hf) {
            const size_t ro = (size_t)hf * (M / 2);
            if (IN(pb + 13)) {
                pg8::Gemm g{XRES + ro * DM, Wup_t, M / 2, DFF, DM}; pg8::StaticOrder S; S.init(M / 2, DFF, G, bx);
                build_rtab(S, SSP + ro * 32, (LAS float*)(lds + 132096));
                pg8::EpiBf16<1, false, DFF / 256> E{HID + (MK_PER_PHASE ? ro * DFF : 0), DFF, 1.f, nullptr, 0, (const LAS float*)(lds + 132096), 0};
                pg8::gemm_phase<pg8::EpiBf16<1, false, DFF / 256>, pg8::StaticOrder, PG8_ALIGN, PG8_SP2>(lds + RING_OFF, g, S, E);
            }
            if (IN(pb + 13) && IN(pb + 14)) xcd_barrier(bar);
            if (IN(pb + 14)) {
                pg8::Gemm g{HID + (MK_PER_PHASE ? ro * DFF : 0), Wdown_t, M / 2, DM, DFF}; pg8::StaticOrder S; S.init(M / 2, DM, G, bx);
                pg8::EpiResBf16<false> E{XRES + ro * DM, XRES + ro * DM, SSP + ro * 32};
                pg8::gemm_phase<pg8::EpiResBf16<false>, pg8::StaticOrder, PG8_ALIGN, PG8_SP2, true>(lds + RING_OFF, g, S, E);
            }
            if (hf == 0 && IN(pb + 13) && IN(pb + 14)) xcd_barrier(bar);
        }
        SEAM(pb + 14);
    }
    if (IN(DEPTH * NPH)) { PH_IDS
        const float* fg = args.in[17];
#if MK_TIME_A >= 0 || MK_TIME_B >= 0
        xcd_barrier(bar);
#define TPREV(k) ((k) == 9 ? 7 : ((k) == 14 ? 11 : ((k) == 2 ? 0 : (k) - 1)))
#define TDUR(k) ((float)((TS[k] - ((k) == 0 ? TS[63] : TS[TPREV(k)])) + (TS[NPH + (k)] - TS[NPH + TPREV(k)])) * 0.01f)
#endif
#if MK_TIME_A >= 0
#if MK_TIME_A == 120
        const float tscale_ = 1.f + (float)(TS[36] + TS[37]) * 0.01f * (1.f / MK_TIME_DIV);
#elif MK_TIME_A >= 130 && MK_TIME_A <= 134
        const float tscale_ = 1.f + (float)TS[46 + MK_TIME_A - 130] * 0.01f * (1.f / MK_TIME_DIV);
#elif MK_TIME_A == 121
        const float tscale_ = 1.f + (float)(TS[38] + TS[39]) * 0.01f * (1.f / MK_TIME_DIV);
#elif MK_TIME_A == 110
        const float tscale_ = 1.f + (float)((TS[34] - TS[3]) + (TS[35] - TS[NPH + 3])) * 0.01f * (1.f / MK_TIME_DIV);
#elif MK_TIME_A == 200
        const float tscale_ = 1.f + (float)(TS[2 * NPH - 1] - TS[63]) * 0.01f * (1.f / MK_TIME_DIV);
#elif MK_TIME_A >= 101
        const float tscale_ = 1.f + (float)(TS[40 + MK_TIME_A - 100] - (MK_TIME_A == 101 ? TS[32] : TS[40 + MK_TIME_A - 101])) * 0.01f * (1.f / MK_TIME_DIV);
#elif MK_TIME_A == 100
        const float tscale_ = 1.f + (float)((TS[32] - TS[5]) + (TS[33] - TS[NPH + 5])) * 0.01f * (1.f / MK_TIME_DIV);
#else
        const float tscale_ = 1.f + TDUR(MK_TIME_A) * (1.f / MK_TIME_DIV);
#endif
#endif
#if MK_TIME_B >= 0
        const float tspike_ = TDUR(MK_TIME_B) * 0.1f;
#endif
        for (int m0 = gw; m0 < M; m0 += 2 * NGW) {
            const int m1 = m0 + NGW < M ? m0 + NGW : m0;
            unsigned long long wa[8], wb[8]; f32x4 g4[8];
            const unsigned long long* ha = (const unsigned long long*)(XRES + (size_t)m0 * DM) + lane; const unsigned long long* hb = (const unsigned long long*)(XRES + (size_t)m1 * DM) + lane;
            float pa = SSP[(size_t)m0 * 32 + (lane & 31)], pb = SSP[(size_t)m1 * 32 + (lane & 31)];
#pragma unroll
            for (int j = 0; j < 8; ++j) { wa[j] = ha[64 * j]; wb[j] = hb[64 * j]; g4[j] = ((const f32x4*)fg + lane)[64 * j]; }
            asm volatile("" : "+v"(pa), "+v"(pb) :: "memory");
            if (lane >= 32) { pa = 0.f; pb = 0.f; }
            const float rsa = 1.0f / sqrtf(wave_sum(pa) * (1.f / DM) + EPS), rsb = 1.0f / sqrtf(wave_sum(pb) * (1.f / DM) + EPS);
#pragma unroll
            for (int k = 0; k < 2; ++k) { if (k == 1 && m1 == m0) break; const int m = k ? m1 : m0; const float rs = k ? rsb : rsa; f32x4* xr = (f32x4*)(out + (size_t)m * DM) + lane;
#pragma unroll
                for (int j = 0; j < 8; ++j) { const unsigned long long w = k ? wb[j] : wa[j]; const unsigned lo = (unsigned)w, hi2 = (unsigned)(w >> 32);
                    const f32x4 v = {__uint_as_float(lo << 16), __uint_as_float(lo & 0xffff0000u), __uint_as_float(hi2 << 16), __uint_as_float(hi2 & 0xffff0000u)};
#if MK_TIME_A >= 0
                    xr[64 * j] = v * rs * g4[j] * tscale_;
#else
                    xr[64 * j] = v * rs * g4[j];
#endif
                }
#if MK_TIME_B >= 0
                if (m == 0 && lane == 0) out[0] += tspike_;
#endif
            }
        }
    }
#undef IN
#undef SEAM
}

extern "C" void kernel_launch(void* const* d_in, const int* in_sizes, int n_in, void* d_out, int out_size, void* d_ws, size_t ws_size, hipStream_t stream) {
    static int grid = 0;
    if (grid == 0) {
        if (n_in != 18 || in_sizes[0] != M * DM || out_size != M * DM || ws_size < WS_END) {
            fprintf(stderr, "kernel_launch: shape / workspace mismatch (n_in %d, in0 %d, out %d, ws %zu, need %zu); nothing launched\n", n_in, n_in > 0 ? in_sizes[0] : -1, out_size, ws_size, (size_t)WS_END); grid = -1; return; }
        int dev = 0, cus = 0, per_cu = 0;
        if (hipGetDevice(&dev) != hipSuccess || hipDeviceGetAttribute(&cus, hipDeviceAttributeMultiprocessorCount, dev) != hipSuccess) { grid = -1; return; }
        if (hipFuncSetAttribute((const void*)enc_fwd, hipFuncAttributeMaxDynamicSharedMemorySize, LDS_BYTES) != hipSuccess) { fprintf(stderr, "kernel_launch: hipFuncSetAttribute failed\n"); grid = -1; return; }
        if (hipOccupancyMaxActiveBlocksPerMultiprocessor(&per_cu, (const void*)enc_fwd, NWAVES * 64, LDS_BYTES) != hipSuccess || per_cu < 1) { fprintf(stderr, "kernel_launch: occupancy query says %d blocks per CU\n", per_cu); }
        (void)hipGetLastError();
        grid = cus;
    }
    if (grid < 0) return;
    if (hipMemsetAsync((char*)d_ws + WS_CTL, 0, CTL_ZERO_BYTES, stream) != hipSuccess) return;
    Args a{};
    for (int i = 0; i < 18; ++i) a.in[i] = (const float*)d_in[i];
    a.out = (float*)d_out; a.ws = (unsigned char*)d_ws;
#if MK_PER_PHASE
    for (int p = 0; p < NPHT; ++p) { a.ph_lo = p; a.ph_hi = p + 1; hipLaunchKernelGGL(enc_fwd, dim3(grid), dim3(NWAVES * 64), LDS_BYTES, stream, a); }
#else
    a.ph_lo = 0; a.ph_hi = NPHT;
    hipLaunchKernelGGL(enc_fwd, dim3(grid), dim3(NWAVES * 64), LDS_BYTES, stream, a);
#endif
    const hipError_t le = hipPeekAtLastError();
    if (le != hipSuccess) fprintf(stderr, "kernel_launch: launch failed: %s\n", hipGetErrorName(le));
}
```
